# Optimizing an MI355X kernel written in HIP

```python
import jax, jax.numpy as jnp
from jax import lax
import numpy as np

D_MODEL = 2048
BATCH = 1
SEQ = 16384
DEPTH = 1

CHUNK = 128
SGU_GROUPS = 8
SGU_WIDTH = 1024
SGU_CH = SGU_WIDTH // SGU_GROUPS
ATTN_HEADS = 8
HEAD_DIM = 128
ATTN_WIDTH = ATTN_HEADS * HEAD_DIM
IDX_HEADS = 16
IDX_DIM = 64
TOPK_MAX = 256
Q_BLOCK = 128
D_FF = 5504
N_ADA = 9
EPS = 1e-6
NEG = -1e30
IN_SIZES = (SGU_WIDTH, SGU_WIDTH,
            ATTN_WIDTH, ATTN_WIDTH, ATTN_WIDTH,
            IDX_HEADS * IDX_DIM, IDX_DIM, IDX_HEADS,
            D_MODEL, D_MODEL)
IN_WIDTH = sum(IN_SIZES)

kernel_name = "hybrid_gmlp_dsa_macaron_adaln"


def _rmsnorm(x, g):
    xf = x.astype(jnp.float32)
    y = xf * lax.rsqrt(jnp.mean(xf * xf, axis=-1, keepdims=True) + EPS)
    return (y * g.astype(jnp.float32)).astype(x.dtype)


def _layernorm(x, g, b):
    xf = x.astype(jnp.float32)
    mu = jnp.mean(xf, axis=-1, keepdims=True)
    var = jnp.mean(jnp.square(xf - mu), axis=-1, keepdims=True)
    y = (xf - mu) * lax.rsqrt(var + EPS)
    return (y * g.astype(jnp.float32) + b.astype(jnp.float32)).astype(x.dtype)


def _modulate(n, shift, scale):
    return n * (1 + scale) + shift


def _swiglu(n, w_gate, w_up, w_down):
    return (jax.nn.silu(n @ w_gate) * (n @ w_up)) @ w_down


def _split_cols(z, sizes):
    out, start = [], 0
    for s in sizes:
        out.append(z[..., start:start + s])
        start += s
    return out


def _alibi_slopes(n_heads):
    h = jnp.arange(1, n_heads + 1, dtype=jnp.float32)
    return jnp.exp2(-8.0 * h / n_heads)


def _chunked_sgu(u, v, g_sgu, w_spatial, b_spatial):
    B, S, _ = u.shape
    nc = S // CHUNK
    v = _rmsnorm(v.reshape(B, S, SGU_GROUPS, SGU_CH), g_sgu.reshape(SGU_GROUPS, SGU_CH))
    vc = v.reshape(B, nc, CHUNK, SGU_GROUPS, SGU_CH)
    causal = jnp.tril(jnp.ones((CHUNK, CHUNK), dtype=bool))
    ws = jnp.where(causal[None], w_spatial, 0)
    sv = jnp.einsum('gij,bnjgc->bnigc', ws, vc) + jnp.transpose(b_spatial)[None, None, :, :, None]
    return (u.reshape(B, nc, CHUNK, SGU_GROUPS, SGU_CH) * sv).reshape(B, S, SGU_WIDTH)


def _dsa_attention(q, k, v, q_idx, k_idx, w_idx):
    B, S = q.shape[:2]
    topk = min(TOPK_MAX, S // 4)
    nb = S // Q_BLOCK
    pos = jnp.arange(S, dtype=jnp.int32)
    slopes = _alibi_slopes(ATTN_HEADS)
    kf = k_idx.astype(jnp.float32)
    scale = HEAD_DIM ** -0.5

    def to_blocks(a):
        return jnp.moveaxis(a.reshape(B, nb, Q_BLOCK, *a.shape[2:]), 1, 0)

    def block(args):
        qb, qib, wb, tb = args
        rel = jax.nn.relu(jnp.einsum('bqhd,bsd->bqhs', qib.astype(jnp.float32), kf))
        iscore = jnp.einsum('bqhs,bqh->bqs', rel, wb.astype(jnp.float32))
        admissible = pos[None, :] <= tb[:, None]
        iscore = jnp.where(admissible[None], iscore, NEG)
        _, sel = lax.top_k(iscore, topk)
        valid = sel <= tb[None, :, None]
        k_sel = jax.vmap(lambda kk, ss: kk[ss])(k, sel)
        v_sel = jax.vmap(lambda vv, ss: vv[ss])(v, sel)
        logits = jnp.einsum('bqhd,bqkhd->bhqk', qb.astype(jnp.float32), k_sel.astype(jnp.float32)) * scale
        dist = (tb[None, :, None] - sel).astype(jnp.float32)
        logits = logits - slopes[None, :, None, None] * dist[:, None]
        logits = jnp.where(valid[:, None], logits, NEG)
        p = jax.nn.softmax(logits, axis=-1)
        o = jnp.einsum('bhqk,bqkhd->bqhd', p, v_sel.astype(jnp.float32))
        return o.astype(q.dtype)

    out = lax.map(block, (to_blocks(q), to_blocks(q_idx), to_blocks(w_idx), pos.reshape(nb, Q_BLOCK)))
    return jnp.moveaxis(out, 0, 1).reshape(B, S, ATTN_WIDTH)


def _decoder_layer(x, c, w_ada, b_ada, g_norm1, w1_gate, w1_up, w1_down, g_norm2, w_in,
                   g_sgu, w_spatial, b_spatial, g_q, g_k, g_kidx, b_kidx,
                   w_branch_a, w_branch_b, w_out, g_norm3, w2_gate, w2_up, w2_down):
    B, S, _ = x.shape
    ada = jax.nn.silu(c) @ w_ada + b_ada
    sh1, sc1, gt1, sh2, sc2, gt2, sh3, sc3, gt3 = jnp.split(ada[:, None, :], N_ADA, axis=-1)

    n = _modulate(_rmsnorm(x, g_norm1), sh1, sc1)
    x = x + 0.5 * gt1 * _swiglu(n, w1_gate, w1_up, w1_down)

    n = _modulate(_rmsnorm(x, g_norm2), sh2, sc2)
    z = n @ w_in
    u, v, q, k, vv, qi, ki, wi, ga, gb = _split_cols(z, IN_SIZES)

    y_a = _chunked_sgu(jax.nn.gelu(u), jax.nn.gelu(v), g_sgu, w_spatial, b_spatial) @ w_branch_a

    q = _rmsnorm(q.reshape(B, S, ATTN_HEADS, HEAD_DIM), g_q)
    k = _rmsnorm(k.reshape(B, S, ATTN_HEADS, HEAD_DIM), g_k)
    vv = vv.reshape(B, S, ATTN_HEADS, HEAD_DIM)
    qi = qi.reshape(B, S, IDX_HEADS, IDX_DIM)
    ki = _layernorm(ki, g_kidx, b_kidx)
    wi = wi * (IDX_HEADS ** -0.5 * IDX_DIM ** -0.5)
    y_b = _dsa_attention(q, k, vv, qi, ki, wi) @ w_branch_b

    merged = jax.nn.sigmoid(ga) * y_a + jax.nn.sigmoid(gb) * y_b
    x = x + gt2 * (merged @ w_out)

    n = _modulate(_rmsnorm(x, g_norm3), sh3, sc3)
    x = x + 0.5 * gt3 * _swiglu(n, w2_gate, w2_up, w2_down)
    return x


def setup_inputs(seed: int = 0) -> dict:
    key = jax.random.key(seed)
    ks = jax.random.split(key, 24)
    f32 = jnp.float32
    L, D = DEPTH, D_MODEL

    def nrm(k, shape, s):
        return jax.random.normal(k, shape, f32) * s

    def gain(k, shape):
        return 1.0 + 0.02 * jax.random.normal(k, shape, f32)

    return {
        "x": nrm(ks[0], (BATCH, SEQ, D), 1.0),
        "c": nrm(ks[1], (BATCH, D), 1.0),
        "w_ada": nrm(ks[2], (L, D, N_ADA * D), 0.5 * D ** -0.5),
        "b_ada": nrm(ks[3], (L, N_ADA * D), 0.01),
        "g_norm1": gain(ks[4], (L, D)),
        "w1_gate": nrm(ks[5], (L, D, D_FF), D ** -0.5),
        "w1_up": nrm(ks[6], (L, D, D_FF), D ** -0.5),
        "w1_down": nrm(ks[7], (L, D_FF, D), D_FF ** -0.5),
        "g_norm2": gain(ks[8], (L, D)),
        "w_in": nrm(ks[9], (L, D, IN_WIDTH), D ** -0.5),
        "g_sgu": gain(ks[10], (L, SGU_WIDTH)),
        "w_spatial": nrm(ks[11], (L, SGU_GROUPS, CHUNK, CHUNK), CHUNK ** -0.5),
        "b_spatial": 1.0 + nrm(ks[12], (L, SGU_GROUPS, CHUNK), 0.1),
        "g_q": gain(ks[13], (L, HEAD_DIM)),
        "g_k": gain(ks[14], (L, HEAD_DIM)),
        "g_kidx": gain(ks[15], (L, IDX_DIM)),
        "b_kidx": nrm(ks[16], (L, IDX_DIM), 0.02),
        "w_branch_a": nrm(ks[17], (L, SGU_WIDTH, D), SGU_WIDTH ** -0.5),
        "w_branch_b": nrm(ks[18], (L, ATTN_WIDTH, D), ATTN_WIDTH ** -0.5),
        "w_out": nrm(ks[19], (L, D, D), D ** -0.5),
        "g_norm3": gain(ks[20], (L, D)),
        "w2_gate": nrm(ks[21], (L, D, D_FF), D ** -0.5),
        "w2_up": nrm(ks[22], (L, D, D_FF), D ** -0.5),
        "w2_down": nrm(ks[23], (L, D_FF, D), D_FF ** -0.5),
    }


def reference(x, c, w_ada, b_ada, g_norm1, w1_gate, w1_up, w1_down, g_norm2, w_in,
              g_sgu, w_spatial, b_spatial, g_q, g_k, g_kidx, b_kidx,
              w_branch_a, w_branch_b, w_out, g_norm3, w2_gate, w2_up, w2_down):
    for l in range(DEPTH):
        x = _decoder_layer(x, c, w_ada[l], b_ada[l], g_norm1[l], w1_gate[l], w1_up[l], w1_down[l],
                           g_norm2[l], w_in[l], g_sgu[l], w_spatial[l], b_spatial[l], g_q[l], g_k[l],
                           g_kidx[l], b_kidx[l], w_branch_a[l], w_branch_b[l], w_out[l], g_norm3[l],
                           w2_gate[l], w2_up[l], w2_down[l])
    return x
```

```cpp
#include <hip/hip_runtime.h>
#include <cstdio>
#include <cstdint>

#define LAS __attribute__((address_space(3)))
#define GAS __attribute__((address_space(1)))
typedef unsigned short f16_t;
typedef _Float16 h16x8 __attribute__((ext_vector_type(8)));
typedef _Float16 h16x2 __attribute__((ext_vector_type(2)));
typedef _Float16 h16x4 __attribute__((ext_vector_type(4)));
typedef short s16x8 __attribute__((ext_vector_type(8)));
typedef short s16x4 __attribute__((ext_vector_type(4)));
typedef float f32x2 __attribute__((ext_vector_type(2)));
typedef float f32x4 __attribute__((ext_vector_type(4)));
typedef float f32x16 __attribute__((ext_vector_type(16)));
typedef unsigned u32x2 __attribute__((ext_vector_type(2)));
typedef unsigned u32x4 __attribute__((ext_vector_type(4)));
typedef int i32x4 __attribute__((ext_vector_type(4)));
typedef int i32x8 __attribute__((ext_vector_type(8)));
typedef unsigned char f8_t;

constexpr int SEQ = 16384, DM = 2048, DFF = 5504, NADA = 9 * DM;
constexpr int SGW = 1024, ATW = 1024, NHEAD = 8, HD = 128, IH = 16, IDIM = 64, TOPK = 256;
constexpr int INW = 10320, INW_PAD = 10496;
constexpr float EPS = 1e-6f;
constexpr bool FFN1_F8 = true, FFN2_F8 = true;
constexpr bool GATE_F8 = true;
constexpr float GATE_MUL = 256.f, M1_MUL = 16.f;
constexpr bool MIX_F8 = true;
constexpr bool WIN_F8 = true;
constexpr int DFF8 = 5632;
constexpr float W_GU_MUL = 32.f, W_D_MUL = 64.f, H_MUL = 4.f;
constexpr float W_AB_MUL = 16.f; constexpr unsigned E8M0_AB = 0x7b7b7b7bu  ;
constexpr unsigned E8M0_1 = 0x7f7f7f7fu, E8M0_GU = 0x7a7a7a7au  , E8M0_DH = 0x77777777u  ;
constexpr int NWAVES = 8, NT = 512;
#define LDS_WAIT() asm volatile("s_waitcnt lgkmcnt(0)" ::: "memory")

__device__ __forceinline__ int lane_id() { int l = (int)__builtin_amdgcn_mbcnt_hi(~0u, __builtin_amdgcn_mbcnt_lo(~0u, 0u)); asm volatile("" : "+v"(l)); return l; }
template <int M> __device__ __forceinline__ float swz_xor(float v) { return __builtin_bit_cast(float, __builtin_amdgcn_ds_swizzle(__builtin_bit_cast(int, v), (M << 10) | 0x1f)); }
__device__ __forceinline__ unsigned pk_h2(float lo, float hi) { f32x2 v = {lo, hi}; return __builtin_bit_cast(unsigned, __builtin_convertvector(v, h16x2)); }
__device__ __forceinline__ unsigned pk_f8x4(float a, float b, float c, float d) { int w = 0; w = __builtin_amdgcn_cvt_pk_fp8_f32(a, b, w, false); w = __builtin_amdgcn_cvt_pk_fp8_f32(c, d, w, true); return (unsigned)w; }
__device__ __forceinline__ float h2f(f16_t h) { return (float)__builtin_bit_cast(_Float16, h); }
__device__ __forceinline__ float fexp2(float x) { return __builtin_amdgcn_exp2f(x); }
__device__ __forceinline__ float frcp(float x) { return __builtin_amdgcn_rcpf(x); }
__device__ __forceinline__ float silu_f(float x) { return x * frcp(1.0f + fexp2(-1.4426950409f * x)); }
__device__ __forceinline__ float sigmoid_f(float x) { return frcp(1.0f + fexp2(-1.4426950409f * x)); }
__device__ __forceinline__ float gelu_f(float x) {
    const float t = x * x; const float e = fexp2(x * (-2.3022081981f - 0.1029432398f * t));
    return x * frcp(1.0f + e);
}

namespace pg8 {
constexpr int BM = 256, BK = 64, HALF = 128, HTB = HALF * BK * 2, STAGE_BYTES = 8 * HTB, NXCD = 8, WGM = 8;
__host__ __device__ __forceinline__ int lds_byte(int r, int c) { const int st = (r >> 4) * 2 + (c >> 5), rr = r & 15, cc = c & 31, ob = rr * 64 + cc * 2; return st * 1024 + (ob ^ (((ob >> 9) & 1) << 5)); }
__host__ __device__ __forceinline__ void stage_rc(int b, int& R, int& C) { const int st = b / 1024, sb = b % 1024, swz = sb ^ (((sb >> 9) & 1) << 5); R = (st >> 1) * 16 + swz / 64; C = (st & 1) * 32 + (swz % 64) / 2; }
__host__ __device__ __forceinline__ int perm32(int rho) { const int n = rho >> 4, i = rho & 15; return 8 * (i >> 2) + 4 * n + (i & 3); }

struct Unit { int pm, pn; };
struct Gemm { const f16_t* A; const f16_t* Bt; int M, N, K; unsigned sca, scb; };

struct StaticOrder {
    int nM, nN, nwg, G, c;
    __host__ __device__ void init(int M, int N, int G_, int c_) { nM = M / BM; nN = N / BM; nwg = nM * nN; G = G_; c = c_; }
    __host__ __device__ bool next(int i, Unit& u) const {
        const long L = (long)i * G + c; if (L >= nwg) return false;
        int wgid = (int)L; { const int q = nwg / NXCD, r = nwg % NXCD, xcd = wgid % NXCD, off = wgid / NXCD; wgid = (xcd < r ? xcd * (q + 1) : r * (q + 1) + (xcd - r) * q) + off; }
        const int nig = WGM * nN, gid = wgid / nig, fm = gid * WGM, gsz = (nM - fm) < WGM ? (nM - fm) : WGM;
        u.pm = fm + ((wgid % nig) % gsz); u.pn = (wgid % nig) / gsz; return true;
    }
    __device__ __forceinline__ void a_ready(const Unit&) const {}
    __device__ __forceinline__ void done(const Unit&) const {}
};

template <bool OUT8> struct EpiSwiGLU {
    static constexpr bool PERM = true, AFTER_DRAIN = false;
    void* H; int ldc;
    __device__ __forceinline__ void operator()(const f32x4 (&acc)[2][2][4][2], const Unit& u, int wr, int wc, int fr, int fq) const {
        const int row0 = u.pm * BM + wr * 64 + fr, col0 = u.pn * HALF + wc * 32 + 8 * fq;
#pragma unroll
        for (int ai = 0; ai < 2; ++ai)
#pragma unroll
            for (int m = 0; m < 4; ++m) {
                const f32x4 g0 = acc[ai][0][m][0], g1 = acc[ai][0][m][1], u0 = acc[ai][1][m][0], u1 = acc[ai][1][m][1];
                float h[8];
#pragma unroll
                for (int j = 0; j < 4; ++j) { h[j] = silu_f(g0[j]) * u0[j]; h[4 + j] = silu_f(g1[j]) * u1[j]; }
                if (OUT8) { u32x2 w; w.x = pk_f8x4(h[0] * H_MUL, h[1] * H_MUL, h[2] * H_MUL, h[3] * H_MUL); w.y = pk_f8x4(h[4] * H_MUL, h[5] * H_MUL, h[6] * H_MUL, h[7] * H_MUL);
                    *(u32x2*)((f8_t*)H + (size_t)(row0 + ai * HALF + m * 16) * ldc + col0) = w; }
                else { u32x4 w; w.x = pk_h2(h[0], h[1]); w.y = pk_h2(h[2], h[3]); w.z = pk_h2(h[4], h[5]); w.w = pk_h2(h[6], h[7]);
                    *(u32x4*)((f16_t*)H + (size_t)(row0 + ai * HALF + m * 16) * ldc + col0) = w; }
            }
    }
};
template <bool BIN_H, bool OUT_H> struct EpiResidH {
    static constexpr bool PERM = true, AFTER_DRAIN = false;
    const void* base; void* out; const float* gate; float gscale; int ldc;
    __device__ __forceinline__ void operator()(const f32x4 (&acc)[2][2][4][2], const Unit& u, int wr, int wc, int fr, int fq) const {
        const int row0 = u.pm * BM + wr * 64 + fr, col0 = u.pn * BM + wc * 32 + 8 * fq;
        f32x4 gv[2][2];
#pragma unroll
        for (int bj = 0; bj < 2; ++bj)
#pragma unroll
            for (int n = 0; n < 2; ++n) gv[bj][n] = *(const f32x4*)(gate + col0 + bj * HALF + n * 4) * gscale;
#pragma unroll
        for (int ai = 0; ai < 2; ++ai)
#pragma unroll
            for (int m = 0; m < 4; ++m) { const size_t off = (size_t)(row0 + ai * HALF + m * 16) * ldc + col0;
#pragma unroll
                for (int bj = 0; bj < 2; ++bj) { f32x4 b0, b1;
                    if (BIN_H) { const h16x8 hb = *(const h16x8*)((const f16_t*)base + off + bj * HALF); b0 = (f32x4){(float)hb[0], (float)hb[1], (float)hb[2], (float)hb[3]}; b1 = (f32x4){(float)hb[4], (float)hb[5], (float)hb[6], (float)hb[7]}; }
                    else { b0 = *(const f32x4*)((const float*)base + off + bj * HALF); b1 = *(const f32x4*)((const float*)base + off + bj * HALF + 4); }
                    const f32x4 r0 = b0 + gv[bj][0] * acc[ai][bj][m][0], r1 = b1 + gv[bj][1] * acc[ai][bj][m][1];
                    if (OUT_H) { u32x4 w; w.x = pk_h2(r0[0], r0[1]); w.y = pk_h2(r0[2], r0[3]); w.z = pk_h2(r1[0], r1[1]); w.w = pk_h2(r1[2], r1[3]); *(u32x4*)((f16_t*)out + off + bj * HALF) = w; }
                    else { *(f32x4*)((float*)out + off + bj * HALF) = r0; *(f32x4*)((float*)out + off + bj * HALF + 4) = r1; } } }
    }
};
template <int ACT> __device__ __forceinline__ float act_f(float x) { if (ACT == 1) return gelu_f(x); if (ACT == 2) return sigmoid_f(x); return x; }
template <int ACT> __device__ __forceinline__ void store_tile_f8(const f32x4 (&acc)[2][2][4][2], f8_t* dst, int ldc, int row0, int col0, float mul) {
#pragma unroll
    for (int ai = 0; ai < 2; ++ai)
#pragma unroll
        for (int m = 0; m < 4; ++m) { f8_t* rowp = dst + (size_t)(row0 + ai * HALF + m * 16) * ldc + col0;
#pragma unroll
            for (int bj = 0; bj < 2; ++bj) { const f32x4 v0 = acc[ai][bj][m][0], v1 = acc[ai][bj][m][1]; u32x2 w;
                w.x = pk_f8x4(act_f<ACT>(v0[0]) * mul, act_f<ACT>(v0[1]) * mul, act_f<ACT>(v0[2]) * mul, act_f<ACT>(v0[3]) * mul);
                w.y = pk_f8x4(act_f<ACT>(v1[0]) * mul, act_f<ACT>(v1[1]) * mul, act_f<ACT>(v1[2]) * mul, act_f<ACT>(v1[3]) * mul);
                *(u32x2*)(rowp + bj * HALF) = w; } }
}
template <int ACT> __device__ __forceinline__ void store_tile_h(const f32x4 (&acc)[2][2][4][2], f16_t* dst, int ldc, int row0, int col0) {
#pragma unroll
    for (int ai = 0; ai < 2; ++ai)
#pragma unroll
        for (int m = 0; m < 4; ++m) { f16_t* rowp = dst + (size_t)(row0 + ai * HALF + m * 16) * ldc + col0;
#pragma unroll
            for (int bj = 0; bj < 2; ++bj) { const f32x4 v0 = acc[ai][bj][m][0], v1 = acc[ai][bj][m][1]; u32x4 w;
                w.x = pk_h2(act_f<ACT>(v0[0]), act_f<ACT>(v0[1])); w.y = pk_h2(act_f<ACT>(v0[2]), act_f<ACT>(v0[3]));
                w.z = pk_h2(act_f<ACT>(v1[0]), act_f<ACT>(v1[1])); w.w = pk_h2(act_f<ACT>(v1[2]), act_f<ACT>(v1[3]));
                *(u32x4*)(rowp + bj * HALF) = w; } }
}
struct EpiWIN {
    static constexpr bool PERM = true, AFTER_DRAIN = false;
    f16_t* Z6;
    f16_t* GAB;
    f16_t* KI; float* WI;
    const float* gki; const float* bki;
    const float* gq; const float* gk;
    LAS float* xch;
    int mode;
    __device__ __forceinline__ void operator()(const f32x4 (&acc)[2][2][4][2], const Unit& u, int wr, int wc, int fr, int fq) const {
        const int row0 = u.pm * BM + wr * 64 + fr, cin = wc * 32 + 8 * fq;
        const int pn = mode == 0 ? u.pn : (mode == 1 ? (u.pn < 20 ? u.pn : u.pn + 4) : (u.pn < 4 ? 20 + u.pn : 40));
        if (pn < 8) { store_tile_h<1>(acc, Z6 + (size_t)(pn >> 2) * SEQ * 1024, 1024, row0, (pn & 3) * 256 + cin); }
        else if (pn < 16) {
            const float* g = pn < 12 ? gq : gk;
            float ss[2][4][2];
#pragma unroll
            for (int ai = 0; ai < 2; ++ai)
#pragma unroll
                for (int m = 0; m < 4; ++m)
#pragma unroll
                    for (int bj = 0; bj < 2; ++bj) { const f32x4 a = acc[ai][bj][m][0], b = acc[ai][bj][m][1];
                        float t = (a[0] * a[0] + a[1] * a[1]) + (a[2] * a[2] + a[3] * a[3]) + (b[0] * b[0] + b[1] * b[1]) + (b[2] * b[2] + b[3] * b[3]);
                        t += __shfl_xor(t, 16); t += __shfl_xor(t, 32); ss[ai][m][bj] = t; }
            if (fq == 0) {
#pragma unroll
                for (int ai = 0; ai < 2; ++ai)
#pragma unroll
                    for (int m = 0; m < 4; ++m)
#pragma unroll
                        for (int bj = 0; bj < 2; ++bj) xch[((ai * HALF + wr * 64 + m * 16 + fr) * 2 + bj) * 4 + wc] = ss[ai][m][bj]; }
            asm volatile("s_waitcnt lgkmcnt(0)" ::: "memory"); __builtin_amdgcn_s_barrier(); asm volatile("" ::: "memory");
            f32x4 gv[2]; gv[0] = *(const f32x4*)(g + cin); gv[1] = *(const f32x4*)(g + cin + 4);
            f16_t* dst = Z6 + (size_t)(pn >> 2) * SEQ * 1024; const int col0 = (pn & 3) * 256 + cin;
#pragma unroll
            for (int ai = 0; ai < 2; ++ai)
#pragma unroll
                for (int m = 0; m < 4; ++m) { f16_t* rowp = dst + (size_t)(row0 + ai * HALF + m * 16) * 1024 + col0;
#pragma unroll
                    for (int bj = 0; bj < 2; ++bj) { const f32x4 pr = *(const LAS f32x4*)(xch + ((ai * HALF + wr * 64 + m * 16 + fr) * 2 + bj) * 4);
                        const float r = 1.0f / sqrtf(((pr[0] + pr[1]) + (pr[2] + pr[3])) * (1.0f / 128) + EPS);
                        const f32x4 v0 = acc[ai][bj][m][0] * gv[0] * r, v1 = acc[ai][bj][m][1] * gv[1] * r; u32x4 w;
                        w.x = pk_h2(v0[0], v0[1]); w.y = pk_h2(v0[2], v0[3]); w.z = pk_h2(v1[0], v1[1]); w.w = pk_h2(v1[2], v1[3]);
                        *(u32x4*)(rowp + bj * HALF) = w; } }
        }
        else if (pn < 24) { store_tile_h<0>(acc, Z6 + (size_t)(pn >> 2) * SEQ * 1024, 1024, row0, (pn & 3) * 256 + cin); }
        else if (pn < 40) { if (GATE_F8) store_tile_f8<2>(acc, (f8_t*)GAB + (size_t)((pn - 24) >> 3) * SEQ * 2048, 2048, row0, ((pn - 24) & 7) * 256 + cin, GATE_MUL);
                            else store_tile_h<2>(acc, GAB + (size_t)((pn - 24) >> 3) * SEQ * 2048, 2048, row0, ((pn - 24) & 7) * 256 + cin); }
        else {
            float s1[2][4], s2[2][4];
#pragma unroll
            for (int ai = 0; ai < 2; ++ai)
#pragma unroll
                for (int m = 0; m < 4; ++m) { const f32x4 a = acc[ai][0][m][0], b = acc[ai][0][m][1];
                    float t1 = (a[0] + a[1]) + (a[2] + a[3]) + (b[0] + b[1]) + (b[2] + b[3]);
                    float t2 = (a[0] * a[0] + a[1] * a[1]) + (a[2] * a[2] + a[3] * a[3]) + (b[0] * b[0] + b[1] * b[1]) + (b[2] * b[2] + b[3] * b[3]);
                    t1 += __shfl_xor(t1, 16); t1 += __shfl_xor(t1, 32); t2 += __shfl_xor(t2, 16); t2 += __shfl_xor(t2, 32); s1[ai][m] = t1; s2[ai][m] = t2; }
            if (fq == 0 && wc < 2) {
#pragma unroll
                for (int ai = 0; ai < 2; ++ai)
#pragma unroll
                    for (int m = 0; m < 4; ++m) { const int rl = ai * HALF + wr * 64 + m * 16 + fr; xch[(rl * 4 + wc) * 2] = s1[ai][m]; xch[(rl * 4 + wc) * 2 + 1] = s2[ai][m]; } }
            asm volatile("s_waitcnt lgkmcnt(0)" ::: "memory"); __builtin_amdgcn_s_barrier(); asm volatile("" ::: "memory");
            if (wc < 2) {
                const f32x4 g0 = *(const f32x4*)(gki + cin), g1 = *(const f32x4*)(gki + cin + 4), b0 = *(const f32x4*)(bki + cin), b1 = *(const f32x4*)(bki + cin + 4);
#pragma unroll
                for (int ai = 0; ai < 2; ++ai)
#pragma unroll
                    for (int m = 0; m < 4; ++m) { const int rl = ai * HALF + wr * 64 + m * 16 + fr; const f32x4 pr = *(const LAS f32x4*)(xch + rl * 8);
                        const float mu = (pr[0] + pr[2]) * (1.0f / IDIM), var = fmaxf((pr[1] + pr[3]) * (1.0f / IDIM) - mu * mu, 0.f), r = 1.0f / sqrtf(var + EPS);
                        const f32x4 v0 = (acc[ai][0][m][0] - mu) * r * g0 + b0, v1 = (acc[ai][0][m][1] - mu) * r * g1 + b1; u32x4 w;
                        w.x = pk_h2(v0[0], v0[1]); w.y = pk_h2(v0[2], v0[3]); w.z = pk_h2(v1[0], v1[1]); w.w = pk_h2(v1[2], v1[3]);
                        *(u32x4*)(KI + (size_t)(row0 + ai * HALF + m * 16) * IDIM + cin) = w; } }
            else if (wc == 2 && fq < 2) {
#pragma unroll
                for (int ai = 0; ai < 2; ++ai)
#pragma unroll
                    for (int m = 0; m < 4; ++m) { float* wp = WI + (size_t)(row0 + ai * HALF + m * 16) * IH + (cin - 64);
                        *(f32x4*)wp = acc[ai][0][m][0] * 0.03125f; *(f32x4*)(wp + 4) = acc[ai][0][m][1] * 0.03125f; } }
        }
    }
};
template <bool ADD, bool OUT8 = false> struct EpiBranch {
    static constexpr bool PERM = true, AFTER_DRAIN = false;
    const f16_t* G; f16_t* M1; int ldc; f8_t* O8;
    __device__ __forceinline__ void operator()(const f32x4 (&acc)[2][2][4][2], const Unit& u, int wr, int wc, int fr, int fq) const {
        const int row0 = u.pm * BM + wr * 64 + fr, col0 = u.pn * BM + wc * 32 + 8 * fq;
#pragma unroll
        for (int ai = 0; ai < 2; ++ai)
#pragma unroll
            for (int m = 0; m < 4; ++m) { const size_t off = (size_t)(row0 + ai * HALF + m * 16) * ldc + col0;
#pragma unroll
                for (int bj = 0; bj < 2; ++bj) {
                    const f32x4 v0 = acc[ai][bj][m][0], v1 = acc[ai][bj][m][1];
                    float r[8];
                    if (GATE_F8) { const u32x2 g = *(const u32x2*)((const f8_t*)G + off + bj * HALF);
                        const f32x2 g0 = __builtin_amdgcn_cvt_pk_f32_fp8((int)g.x, false), g1 = __builtin_amdgcn_cvt_pk_f32_fp8((int)g.x, true), g2 = __builtin_amdgcn_cvt_pk_f32_fp8((int)g.y, false), g3 = __builtin_amdgcn_cvt_pk_f32_fp8((int)g.y, true);
                        constexpr float GI = 1.0f / GATE_MUL;
                        r[0] = g0[0] * GI * v0[0]; r[1] = g0[1] * GI * v0[1]; r[2] = g1[0] * GI * v0[2]; r[3] = g1[1] * GI * v0[3];
                        r[4] = g2[0] * GI * v1[0]; r[5] = g2[1] * GI * v1[1]; r[6] = g3[0] * GI * v1[2]; r[7] = g3[1] * GI * v1[3];
                        if (ADD) { const u32x2 q = *(const u32x2*)((const f8_t*)M1 + off + bj * HALF);
                            const f32x2 q0 = __builtin_amdgcn_cvt_pk_f32_fp8((int)q.x, false), q1 = __builtin_amdgcn_cvt_pk_f32_fp8((int)q.x, true), q2 = __builtin_amdgcn_cvt_pk_f32_fp8((int)q.y, false), q3 = __builtin_amdgcn_cvt_pk_f32_fp8((int)q.y, true);
                            constexpr float MI = 1.0f / M1_MUL;
                            r[0] += q0[0] * MI; r[1] += q0[1] * MI; r[2] += q1[0] * MI; r[3] += q1[1] * MI; r[4] += q2[0] * MI; r[5] += q2[1] * MI; r[6] += q3[0] * MI; r[7] += q3[1] * MI; }
                    } else { const h16x8 g = *(const h16x8*)(G + off + bj * HALF);
#pragma unroll
                        for (int j = 0; j < 4; ++j) { r[j] = (float)g[j] * v0[j]; r[4 + j] = (float)g[4 + j] * v1[j]; }
                        if (ADD) { const h16x8 p = *(const h16x8*)(M1 + off + bj * HALF);
#pragma unroll
                            for (int j = 0; j < 8; ++j) r[j] += (float)p[j]; } }
                    if (OUT8) { u32x2 w; w.x = pk_f8x4(r[0], r[1], r[2], r[3]); w.y = pk_f8x4(r[4], r[5], r[6], r[7]); *(u32x2*)(O8 + off + bj * HALF) = w; }
                    else if (GATE_F8) { u32x2 w; w.x = pk_f8x4(r[0] * M1_MUL, r[1] * M1_MUL, r[2] * M1_MUL, r[3] * M1_MUL); w.y = pk_f8x4(r[4] * M1_MUL, r[5] * M1_MUL, r[6] * M1_MUL, r[7] * M1_MUL); *(u32x2*)((f8_t*)M1 + off + bj * HALF) = w; }
                    else { u32x4 w; w.x = pk_h2(r[0], r[1]); w.y = pk_h2(r[2], r[3]); w.z = pk_h2(r[4], r[5]); w.w = pk_h2(r[6], r[7]);
                        *(u32x4*)(M1 + off + bj * HALF) = w; } } }
    }
};

__device__ __forceinline__ i32x8 cat8(h16x8 a, h16x8 b) { const i32x4 x = __builtin_bit_cast(i32x4, a), y = __builtin_bit_cast(i32x4, b); return __builtin_shufflevector(x, y, 0, 1, 2, 3, 4, 5, 6, 7); }
template <class Epi, class Sched, bool ALIGN_EPI = true, bool F8 = false>
__device__ __forceinline__ void gemm_phase(LAS unsigned char* lds, const Gemm g, const Sched& S, const Epi& E, int wid) {
    const int lane = lane_id(), tid = wid * 64 + lane, wr = wid >> 2, wc = wid & 3, fr = lane & 15, fq = lane >> 4;
    const int K = g.K, nt = K / BK;
    unsigned voffA[2], voffB[2];
#pragma unroll
    for (int i = 0; i < 2; ++i) { int R, C; stage_rc(tid * 16 + i * 8192, R, C); const int Rb = Epi::PERM ? ((R & ~31) + perm32(R & 31)) : R;
        voffA[i] = (unsigned)(R * K + C) * 2u; voffB[i] = (unsigned)(Rb * K + C) * 2u; }
    const size_t kstep = (size_t)(BK * 2);
    const size_t hstep = (size_t)HALF * K * 2;
    const size_t tstep = 2 * hstep;
    const unsigned ldsw = (unsigned)wid * 1024u;
    const int aoff = lds_byte(wr * 64 + fr, fq * 8), boff = lds_byte(wc * 32 + fr, fq * 8);
#define PG8_SA(b, h) (((b) * 2 + (h)) * HTB)
#define PG8_SB(b, h) ((4 + (b) * 2 + (h)) * HTB)
#define PG8_STAGE(bufoff, gbase, voff) do { _Pragma("unroll") for (int _i = 0; _i < 2; ++_i) \
        __builtin_amdgcn_global_load_lds((const unsigned*)((const char*)(gbase) + (voff)[_i]), (LAS unsigned*)(lds + (bufoff) + ldsw + _i * 8192), 16, 0, 0); } while (0)
#define PG8_LDA(dst, b, h) do { _Pragma("unroll") for (int m = 0; m < 4; ++m) { const i32x4 lo_ = *(const LAS i32x4*)(pa_ + (PG8_SA(b, h) + m * 2048)), hi_ = *(const LAS i32x4*)(pa_ + (PG8_SA(b, h) + m * 2048 + 1024)); \
        dst[m] = __builtin_shufflevector(lo_, hi_, 0, 1, 2, 3, 4, 5, 6, 7); } } while (0)
#define PG8_LDB(dst, b, h) do { _Pragma("unroll") for (int n = 0; n < 2; ++n) { const i32x4 lo_ = *(const LAS i32x4*)(pb_ + (PG8_SB(b, h) - 65536 + n * 2048)), hi_ = *(const LAS i32x4*)(pb_ + (PG8_SB(b, h) - 65536 + n * 2048 + 1024)); \
        dst[n] = __builtin_shufflevector(lo_, hi_, 0, 1, 2, 3, 4, 5, 6, 7); } } while (0)
#define PG8_H(v, k) __builtin_bit_cast(h16x8, __builtin_shufflevector(v, v, 4 * (k), 4 * (k) + 1, 4 * (k) + 2, 4 * (k) + 3))
#define PG8_MMA(ai, bj, At, Bt) do { __builtin_amdgcn_s_setprio(1); _Pragma("unroll") for (int m = 0; m < 4; ++m) _Pragma("unroll") for (int n = 0; n < 2; ++n) { \
        if constexpr (F8) asm volatile("v_mfma_scale_f32_16x16x128_f8f6f4 %0, %1, %2, %0, %3, %4 op_sel_hi:[0,0,0]" : "+v"(acc[ai][bj][m][n]) : "v"(Bt[n]), "v"(At[m]), "v"(vsca), "v"(vscb)); \
        else { acc[ai][bj][m][n] = __builtin_amdgcn_mfma_f32_16x16x32_f16(PG8_H(Bt[n], 0), PG8_H(At[m], 0), acc[ai][bj][m][n], 0, 0, 0); \
               acc[ai][bj][m][n] = __builtin_amdgcn_mfma_f32_16x16x32_f16(PG8_H(Bt[n], 1), PG8_H(At[m], 1), acc[ai][bj][m][n], 0, 0, 0); } } \
        __builtin_amdgcn_s_setprio(0); } while (0)
#define PG8_WAIT_V(n) asm volatile("s_waitcnt vmcnt(" #n ")" ::: "memory")
#define PG8_WAIT_L(n) asm volatile("s_waitcnt lgkmcnt(" #n ")" ::: "memory")
#define PG8_BAR __builtin_amdgcn_s_barrier()
#define PG8_SCHED __builtin_amdgcn_sched_barrier(0)
    Unit cur, nxt; int ui = 0;
    if (!S.next(0, cur)) return;
    f32x4 acc[2][2][4][2];
#pragma unroll
    for (int a = 0; a < 2; ++a)
#pragma unroll
        for (int b = 0; b < 2; ++b)
#pragma unroll
            for (int m = 0; m < 4; ++m)
#pragma unroll
                for (int n = 0; n < 2; ++n) acc[a][b][m][n] = (f32x4){0.f, 0.f, 0.f, 0.f};
    const LAS unsigned char* pa_ = lds + aoff; const LAS unsigned char* pb_ = lds + 65536 + boff;
    const int vsca = (int)g.sca, vscb = (int)g.scb; (void)vsca; (void)vscb;
    i32x8 At[4], B0[2], B1[2];
    const char* cA = (const char*)g.A + (size_t)cur.pm * tstep; const char* cB = (const char*)g.Bt + (size_t)cur.pn * tstep;
    S.a_ready(cur);
    PG8_STAGE(PG8_SB(0, 0), cB, voffB); PG8_STAGE(PG8_SB(0, 1), cB + hstep, voffB); PG8_STAGE(PG8_SA(0, 0), cA, voffA); PG8_STAGE(PG8_SA(0, 1), cA + hstep, voffA);
    if (wr == 1) PG8_BAR;
    PG8_WAIT_V(2); PG8_BAR;
    PG8_STAGE(PG8_SB(1, 0), cB + kstep, voffB); PG8_STAGE(PG8_SA(1, 0), cA + kstep, voffA); PG8_STAGE(PG8_SB(1, 1), cB + hstep + kstep, voffB);
    PG8_WAIT_V(6); PG8_BAR;
    for (;;) {
        const bool has_next = S.next(ui + 1, nxt);
        const char* nA = has_next ? (const char*)g.A + (size_t)nxt.pm * tstep : cA; const char* nB = has_next ? (const char*)g.Bt + (size_t)nxt.pn * tstep : cB;
        for (int t = 0; t < nt; t += 2) {
            const bool last = (t == nt - 2);
            const char* a1 = cA + (size_t)(t + 1) * kstep;
            const char* a2 = last ? nA : cA + (size_t)(t + 2) * kstep; const char* b2 = last ? nB : cB + (size_t)(t + 2) * kstep;
            const char* a3 = a2 + kstep; const char* b3 = b2 + kstep;
            if (last && has_next) S.a_ready(nxt);
            PG8_LDB(B0, 0, 0); PG8_LDB(B1, 0, 1); PG8_SCHED; PG8_LDA(At, 0, 0); PG8_STAGE(PG8_SA(1, 1), a1 + hstep, voffA);
            PG8_WAIT_V(8); PG8_WAIT_L(0); PG8_BAR; PG8_MMA(0, 0, At, B0); PG8_MMA(0, 1, At, B1); PG8_BAR; PG8_SCHED;
            PG8_LDA(At, 0, 1); PG8_STAGE(PG8_SB(0, 0), b2, voffB); PG8_STAGE(PG8_SB(0, 1), b2 + hstep, voffB); PG8_STAGE(PG8_SA(0, 0), a2, voffA);
            PG8_WAIT_V(8); PG8_WAIT_L(0); PG8_BAR; PG8_MMA(1, 0, At, B0); PG8_MMA(1, 1, At, B1); PG8_BAR; PG8_SCHED;
            PG8_LDB(B0, 1, 0); PG8_LDB(B1, 1, 1); PG8_SCHED; PG8_LDA(At, 1, 0); PG8_STAGE(PG8_SA(0, 1), a2 + hstep, voffA);
            PG8_WAIT_V(8); PG8_WAIT_L(0); PG8_BAR; PG8_MMA(0, 0, At, B0); PG8_MMA(0, 1, At, B1); PG8_BAR; PG8_SCHED;
            PG8_LDA(At, 1, 1); PG8_STAGE(PG8_SB(1, 0), b3, voffB); PG8_STAGE(PG8_SB(1, 1), b3 + hstep, voffB); PG8_STAGE(PG8_SA(1, 0), a3, voffA);
            PG8_WAIT_V(8); PG8_WAIT_L(0); PG8_BAR; PG8_MMA(1, 0, At, B0); PG8_MMA(1, 1, At, B1); PG8_BAR; PG8_SCHED;
        }
        if constexpr (ALIGN_EPI) { if (wr == 0) PG8_BAR; }
        if constexpr (F8) asm volatile("s_nop 15\n\ts_nop 15" ::: "memory");
        E(acc, cur, wr, wc, fr, fq); S.done(cur);
        if (!has_next) break;
#pragma unroll
        for (int a = 0; a < 2; ++a)
#pragma unroll
            for (int b = 0; b < 2; ++b)
#pragma unroll
                for (int m = 0; m < 4; ++m)
#pragma unroll
                    for (int n = 0; n < 2; ++n) acc[a][b][m][n] = (f32x4){0.f, 0.f, 0.f, 0.f};
        cur = nxt; cA = nA; cB = nB; ++ui;
        if constexpr (ALIGN_EPI) { if (wr == 1) PG8_BAR; }
    }
    PG8_WAIT_V(0);
    if constexpr (!ALIGN_EPI) { if (wr == 0) PG8_BAR; }
    PG8_BAR;
#undef PG8_SA
#undef PG8_SB
#undef PG8_STAGE
#undef PG8_LDA
#undef PG8_H
#undef PG8_LDB
#undef PG8_MMA
#undef PG8_WAIT_V
#undef PG8_WAIT_L
#undef PG8_BAR
#undef PG8_SCHED
}
}


namespace att {
constexpr int D = 128, ASTR = 1024;
constexpr float SCALE = 0.08838834764831845f, THR = 8.f, NEGBIG = -3.0e38f;
constexpr int NW = 8, QBLK = 32, KVBLK = 64, QB = NW * QBLK;
constexpr int SHM_V = KVBLK * D * 2, SHM_K = KVBLK * D * 2;
constexpr int LDS_BYTES = 2 * SHM_V + 2 * SHM_K + NW * 64 * 4;
constexpr size_t PART_O_BYTES = (size_t)QB * D * 2, PART_ML_BYTES = (size_t)QB * 2 * 4;
#define KSWZ(row, colB) ((row) * 256 + ((colB) ^ (((row) & 7) << 4)))
#define SBAR() __builtin_amdgcn_sched_barrier(0)
__device__ __forceinline__ int v_st(int k, int c) { const int kk = (k & ~0xC) | ((k & 4) << 1) | ((k & 8) >> 1); return ((kk >> 3) * 4 + (c >> 5)) * 512 + ((kk & 7) * 32 + (c & 31)) * 2; }
__device__ __forceinline__ int v_rd_base(int lane) { return ((lane & 3) << 3) | (((lane >> 2) & 3) << 6) | (((lane >> 4) & 1) << 5) | (((lane >> 5) & 1) << 8); }
constexpr int v_rd_off(int d0, int ks, int half) { return d0 * 512 + ks * 4096 + half * 2048; }
__device__ __forceinline__ int crow(int r, int hi) { return (r & 3) + 8 * (r >> 2) + 4 * hi; }
__device__ __forceinline__ h16x8 ld8(const f16_t* p) { return *reinterpret_cast<const h16x8*>(p); }
__device__ __forceinline__ float sgprf(float x) { return __uint_as_float(__builtin_amdgcn_readfirstlane(__float_as_uint(x))); }
__device__ __forceinline__ void pinit(f32x16& p0, f32x16& p1, unsigned mlo, unsigned mhi, float sl, float s5, float s32, float base, int hi) {
    const unsigned a = mlo >> (4 * hi), b = mhi >> (4 * hi);
    float v = base, w = base + s32;
    const unsigned NB_ = __float_as_uint(NEGBIG);
#pragma unroll
    for (int r = 0; r < 16; ++r) { const int c = (r & 3) + 8 * (r >> 2);
        const unsigned ma = (unsigned)__builtin_amdgcn_sbfe((int)a, c, 1), mb = (unsigned)__builtin_amdgcn_sbfe((int)b, c, 1);
        p0[r] = __uint_as_float((__float_as_uint(v) & ma) | (NB_ & ~ma));
        p1[r] = __uint_as_float((__float_as_uint(w) & mb) | (NB_ & ~mb));
        if ((r & 3) == 3) { v += s5; w += s5; } else { v += sl; w += sl; } }
}
__device__ __forceinline__ void partialSM(f32x16& p0, f32x16& p1, float& m_reg, float& mn, float& alpha) {
    float pmax = p0[0];
#pragma unroll
    for (int r = 1; r < 16; ++r) pmax = fmaxf(pmax, p0[r]);
#pragma unroll
    for (int r = 0; r < 16; ++r) pmax = fmaxf(pmax, p1[r]);
    { auto rr = __builtin_amdgcn_permlane32_swap(__float_as_uint(pmax), __float_as_uint(pmax), false, false);
      pmax = fmaxf(__uint_as_float(rr[0]), __uint_as_float(rr[1])); }
    constexpr float C2 = 1.4426950408889634f * SCALE;
    if (__builtin_expect(__all((pmax - m_reg) * SCALE <= THR), 1)) { mn = m_reg; alpha = 1.f; }
    else { mn = fmaxf(m_reg, pmax); alpha = __builtin_amdgcn_exp2f((m_reg - mn) * C2); m_reg = mn; }
    const float mnL = -mn * C2;
#pragma unroll
    for (int r = 0; r < 16; ++r) p0[r] = fmaf(p0[r], C2, mnL);
#pragma unroll
    for (int r = 0; r < 16; ++r) p1[r] = fmaf(p1[r], C2, mnL);
#pragma unroll
    for (int r = 0; r < 16; ++r) p0[r] = __builtin_amdgcn_exp2f(p0[r]);
}
__device__ __forceinline__ void finishSM(f32x16& p0, f32x16& p1, float alpha, float& l_reg, h16x8& pa0, h16x8& pa1, h16x8& pa2, h16x8& pa3) {
#pragma unroll
    for (int r = 0; r < 16; ++r) p1[r] = __builtin_amdgcn_exp2f(p1[r]);
    float ps = 0;
#pragma unroll
    for (int r = 0; r < 16; ++r) ps += p0[r];
#pragma unroll
    for (int r = 0; r < 16; ++r) ps += p1[r];
    { auto rr = __builtin_amdgcn_permlane32_swap(__float_as_uint(ps), __float_as_uint(ps), false, false);
      ps = __uint_as_float(rr[0]) + __uint_as_float(rr[1]); }
    l_reg = l_reg * alpha + ps;
#define PK4(P, B_, OUT) do { unsigned a0 = pk_h2(P[B_+0], P[B_+1]), a1 = pk_h2(P[B_+2], P[B_+3]);                          \
        unsigned b0 = pk_h2(P[B_+4], P[B_+5]), b1 = pk_h2(P[B_+6], P[B_+7]);                                             \
        auto r0 = __builtin_amdgcn_permlane32_swap(a0, b0, false, false); auto r1 = __builtin_amdgcn_permlane32_swap(a1, b1, false, false); \
        u32x4 w = {r0[0], r1[0], r0[1], r1[1]}; OUT = __builtin_bit_cast(h16x8, w); } while (0)
    PK4(p0, 0, pa0); PK4(p0, 8, pa1); PK4(p1, 0, pa2); PK4(p1, 8, pa3);
#undef PK4
}
template <int KB>
__device__ __forceinline__ void qkt(f32x16& p0, f32x16& p1, const char* K_lds, int r32, int hi, const h16x8* qr) {
    const char* kb[4];
#pragma unroll
    for (int dd = 0; dd < 4; ++dd) kb[dd] = K_lds + KB * SHM_K + KSWZ(r32, (dd * 16 + hi * 8) * 2);
#pragma unroll
    for (int d0 = 0; d0 < 8; ++d0) { const char* a = kb[d0 & 3] + (d0 >> 2) * 128;
        h16x8 b0 = *reinterpret_cast<const h16x8*>(a);
        h16x8 b1 = *reinterpret_cast<const h16x8*>(a + 32 * 256);
        p0 = __builtin_amdgcn_mfma_f32_32x32x16_f16(b0, qr[d0], p0, 0, 0, 0);
        p1 = __builtin_amdgcn_mfma_f32_32x32x16_f16(b1, qr[d0], p1, 0, 0, 0); }
}
template <int VB>
__device__ __forceinline__ void pv_tile(f32x16* o, int vb0, h16x8 pa0, h16x8 pa1, h16x8 pa2, h16x8 pa3) {
#define TRRD(dst, off) asm volatile("ds_read_b64_tr_b16 %0, %1 offset:%2" : "=&v"(dst) : "v"(vb0), "i"(off) : "memory")
#define CAT8(l, h) __builtin_bit_cast(h16x8, (s16x8){l[0], l[1], l[2], l[3], h[0], h[1], h[2], h[3]})
#define PV_D0(d0) do { s16x4 l0, l1, l2, l3, h0, h1, h2, h3; constexpr int b_ = VB * SHM_V + v_rd_off(d0, 0, 0); \
        TRRD(l0, b_); TRRD(h0, b_ + 2048); TRRD(l1, b_ + 4096); TRRD(h1, b_ + 6144); TRRD(l2, b_ + 8192); TRRD(h2, b_ + 10240); TRRD(l3, b_ + 12288); TRRD(h3, b_ + 14336); \
        asm volatile("s_waitcnt lgkmcnt(0)" ::: "memory"); SBAR();   \
        o[d0] = __builtin_amdgcn_mfma_f32_32x32x16_f16(pa0, CAT8(l0, h0), o[d0], 0, 0, 0);   \
        o[d0] = __builtin_amdgcn_mfma_f32_32x32x16_f16(pa1, CAT8(l1, h1), o[d0], 0, 0, 0);   \
        o[d0] = __builtin_amdgcn_mfma_f32_32x32x16_f16(pa2, CAT8(l2, h2), o[d0], 0, 0, 0);   \
        o[d0] = __builtin_amdgcn_mfma_f32_32x32x16_f16(pa3, CAT8(l3, h3), o[d0], 0, 0, 0); } while (0)
    PV_D0(0); PV_D0(1); PV_D0(2); PV_D0(3);
#undef PV_D0
#undef CAT8
#undef TRRD
}
struct BlockRef { int h, qb, j0, NT, slot; };
struct Ptrs { const f16_t* Q; const f16_t* K; const f16_t* V; f16_t* O; const unsigned long long* M; unsigned char* PART; };
struct Seam { h16x8 qr[8]; h16x8 st_v0, st_v1, st_k0, st_k1; };
#define ROW(p, k0, rr) ((p) + (size_t)((k0) + (rr)) * ASTR + sc)
#define VMW() asm volatile("s_waitcnt vmcnt(0)" ::: "memory")
#define VMWN(n) asm volatile("s_waitcnt vmcnt(%0)" :: "i"(n) : "memory")
#define SLOAD_H(Kp, Vp, k0) do { S.st_v0 = ld8(ROW(Vp, k0, sr)); S.st_v1 = ld8(ROW(Vp, k0, 32 + sr));              \
                         S.st_k0 = ld8(ROW(Kp, k0, sr)); S.st_k1 = ld8(ROW(Kp, k0, 32 + sr)); } while (0)
#define SWRITE_HK(bf) do { *(h16x8*)(K_lds + (bf) * SHM_K + kws) = S.st_k0; *(h16x8*)(K_lds + (bf) * SHM_K + kws + 32 * 256) = S.st_k1; } while (0)
#define SWRITE_HV(bf) do { *(h16x8*)(V_lds + (bf) * SHM_V + vst0) = S.st_v0; *(h16x8*)(V_lds + (bf) * SHM_V + vst1) = S.st_v1; } while (0)
#define SWRITE_H(bf) do { SWRITE_HV(bf); SWRITE_HK(bf); } while (0)
__device__ __forceinline__ void att_prime(const BlockRef& cur, const Ptrs& P, char* lds, Seam& S, int wid) {
    const int lane = lane_id(), tid = wid * 64 + lane, r32 = lane & 31, hi = lane >> 5;
    const int sr = tid >> 4, sc = (tid & 15) * 8, kws = KSWZ(sr, sc * 2); char* K_lds = lds + 2 * SHM_V;
#pragma unroll
    for (int d0 = 0; d0 < 8; ++d0) S.qr[d0] = ld8(P.Q + (size_t)(cur.qb * QB + wid * QBLK + r32) * ASTR + cur.h * D + d0 * 16 + hi * 8);
    SLOAD_H(P.K + cur.h * D, P.V + cur.h * D, cur.j0 * KVBLK); VMW(); SWRITE_HK(0);
    __syncthreads();
}
__device__ __forceinline__ void att_block(const BlockRef& cur, const BlockRef& nxt, const Ptrs& P, char* lds, Seam& S, int wid) {
    const int lane = lane_id(), tid = wid * 64 + lane, r32 = lane & 31, hi = lane >> 5;
    const int NT = cur.NT, j0 = cur.j0;
    const int qrow = cur.qb * QB + wid * QBLK + r32;
    const float sl = __uint_as_float(__builtin_amdgcn_readfirstlane(__float_as_uint(exp2f(-(float)(cur.h + 1)) * (1.0f / SCALE))));
    char* V_lds = lds; char* K_lds = lds + 2 * SHM_V;
    float* ws = (float*)(lds + 2 * SHM_V + 2 * SHM_K) + wid * 64; float* li_l = ws, * al_l = ws + 32;
    float m_reg = -1e30f, l_reg = 0; f32x16 o[4] = {};
    const int sr = tid >> 4, sc = (tid & 15) * 8, vst0 = v_st(sr, sc), vst1 = v_st(32 + sr, sc), kws = KSWZ(sr, sc * 2);
    const int vb0 = (int)(uintptr_t)V_lds + v_rd_base(lane);
    const f16_t* Kh = P.K + cur.h * D; const f16_t* Vh = P.V + cur.h * D;
    const float s5 = sgprf(sl * 5.0f), s32 = sgprf(sl * 32.0f);
    const float sl64 = sl * 64.0f, base0 = -sl * (float)(qrow - 4 * hi - j0 * KVBLK);
#define RESC(a) do { if (__any((a) < 1.f)) { if (hi == 0) al_l[r32] = (a); asm volatile("s_waitcnt lgkmcnt(0)" ::: "memory");              \
                     for (int d_ = 0; d_ < 4; ++d_) for (int r = 0; r < 16; ++r) o[d_][r] *= al_l[crow(r, hi)]; } } while (0)
#define KBASE(t) ((j0 + (t)) * KVBLK)
#define MLOAD(t) (P.M[(size_t)(j0 + (t)) * SEQ + qrow])
#define PINIT(PX0, PX1, mw, t) pinit(PX0, PX1, (unsigned)(mw), (unsigned)((mw) >> 32), sl, s5, s32, fmaf((float)(t), sl64, base0), hi)
    constexpr int NQL = 8;
#define SEAM_K0() do { VMWN(NQL); SWRITE_HK(0); SBAR(); } while (0)
    f32x16 pA0, pA1, pB0, pB1; float mnA, mnB, alA, alB; h16x8 pa0, pa1, pa2, pa3;
    unsigned long long mwc = MLOAD(0);
    SWRITE_HV(0); SBAR();
    SLOAD_H(Kh, Vh, KBASE(1));
    SBAR(); PINIT(pA0, pA1, mwc, 0); mwc = MLOAD(1); qkt<0>(pA0, pA1, K_lds, r32, hi, S.qr);
    partialSM(pA0, pA1, m_reg, mnA, alA);
    VMWN(1); SWRITE_H(1);
    __syncthreads();
#define HALF_STEP(PX0, PX1, mnX, alX, PY0, PY1, alY, t, KB, VB, SB) do {                                                      \
        SBAR(); PINIT(PX0, PX1, mwc, t); if ((t) + 1 < NT) mwc = MLOAD((t) + 1);                                              \
        qkt<KB>(PX0, PX1, K_lds, r32, hi, S.qr);                                                                               \
        finishSM(PY0, PY1, alY, l_reg, pa0, pa1, pa2, pa3); SBAR();                                                           \
        if ((t) + 1 < NT) { SLOAD_H(Kh, Vh, KBASE((t) + 1)); SBAR(); }                                                         \
        pv_tile<VB>(o, vb0, pa0, pa1, pa2, pa3); partialSM(PX0, PX1, m_reg, mnX, alX);                                        \
        __syncthreads();                                                                                                      \
        if ((t) + 1 < NT) { VMW(); SWRITE_H(SB); }                                                                            \
        RESC(alX); __syncthreads(); } while (0)
    for (int t = 1; t + 1 < NT; t += 2) {
        HALF_STEP(pB0, pB1, mnB, alB, pA0, pA1, alA, t, 1, 0, 0);
        HALF_STEP(pA0, pA1, mnA, alA, pB0, pB1, alB, t + 1, 0, 1, 1);
    }
    const bool even = (NT & 1) == 0;
    if (even) { SBAR(); PINIT(pB0, pB1, mwc, NT - 1); qkt<1>(pB0, pB1, K_lds, r32, hi, S.qr); SBAR(); }
    SLOAD_H(P.K + nxt.h * D, P.V + nxt.h * D, nxt.j0 * KVBLK); SBAR();
#pragma unroll
    for (int d0 = 0; d0 < 8; ++d0) S.qr[d0] = ld8(P.Q + (size_t)(nxt.qb * QB + wid * QBLK + r32) * ASTR + nxt.h * D + d0 * 16 + hi * 8);
    SBAR();
    finishSM(pA0, pA1, alA, l_reg, pa0, pa1, pa2, pa3); SBAR();
    pv_tile<0>(o, vb0, pa0, pa1, pa2, pa3);
    if (even) { partialSM(pB0, pB1, m_reg, mnB, alB); __syncthreads(); RESC(alB);
        finishSM(pB0, pB1, alB, l_reg, pa0, pa1, pa2, pa3); SBAR(); pv_tile<1>(o, vb0, pa0, pa1, pa2, pa3); }
    SBAR(); SEAM_K0();
    if (hi == 0) li_l[r32] = l_reg; asm volatile("s_waitcnt lgkmcnt(0)" ::: "memory");
    float rli[16];
#pragma unroll
    for (int r = 0; r < 16; ++r) { const float lv = li_l[crow(r, hi)]; rli[r] = lv > 0.f ? __builtin_amdgcn_rcpf(lv) : 0.f; }
    f16_t* Ow; int ostr;
    if (cur.slot >= 0) { unsigned char* pb = P.PART + (size_t)cur.slot * (PART_O_BYTES + PART_ML_BYTES); Ow = (f16_t*)pb + (size_t)(wid * QBLK) * D; ostr = D;
        if (hi == 0) { float* PML = (float*)(pb + PART_O_BYTES); PML[(wid * QBLK + r32) * 2] = m_reg; PML[(wid * QBLK + r32) * 2 + 1] = l_reg; } }
    else { Ow = P.O + (size_t)(cur.qb * QB + wid * QBLK) * ASTR + cur.h * D; ostr = ASTR; }
    if (MIX_F8 && cur.slot < 0) {
        unsigned char* O8 = (unsigned char*)P.O + (size_t)(cur.qb * QB + wid * QBLK) * ASTR + cur.h * D;
#pragma unroll
        for (int r = 0; r < 16; ++r) { const int orow = crow(r, hi);
#pragma unroll
            for (int d0 = 0; d0 < 4; ++d0) { const float v = o[d0][r] * rli[r];
                const float v1 = swz_xor<1>(v), v2 = swz_xor<2>(v), v3 = swz_xor<2>(v1);
                if ((r32 & 3) == 0) *(unsigned*)(O8 + (size_t)orow * ASTR + d0 * 32 + r32) = pk_f8x4(v, v1, v2, v3); } }
    } else {
#pragma unroll
    for (int r = 0; r < 16; ++r) { const int orow = crow(r, hi);
#pragma unroll
        for (int d0 = 0; d0 < 4; ++d0) { const float v = o[d0][r] * rli[r];
            const float vn = swz_xor<1>(v);
            if ((r32 & 1) == 0) *(unsigned*)(Ow + (size_t)orow * ostr + d0 * 32 + r32) = pk_h2(v, vn); } }
    }
    __syncthreads();
#undef RESC
#undef KBASE
#undef MLOAD
#undef PINIT
#undef SEAM_K0
#undef HALF_STEP
}
#undef ROW
#undef VMW
#undef VMWN
#undef SLOAD_H
#undef SWRITE_HK
#undef SWRITE_HV
#undef SWRITE_H
constexpr int SPLIT_T = 96, MAX_UNITS = 1024; constexpr float MARGIN = 17.0f;
__device__ __forceinline__ int build_units(LAS unsigned char* lds, const unsigned* NEED, int tid) {
    LAS u32x4* tab = (LAS u32x4*)lds; LAS unsigned short* order = (LAS unsigned short*)(lds + 16384); LAS unsigned short* cost = (LAS unsigned short*)(lds + 18432);
    LAS unsigned* sc = (LAS unsigned*)(lds + 20480);
    if (tid < 8) sc[tid] = 0u;
    __syncthreads();
    const int h = tid >> 6, qb = tid & 63, P0 = qb * QB, NTf = 4 * qb + 4;
    const int ks = P0 - (int)NEED[qb * 8 + h];
    int jlo = ks >= -1 ? ((ks + 1) >> 6) : 0; jlo = jlo > NTf - 4 ? NTf - 4 : jlo;
    const int n = NTf - jlo, parts = (n + SPLIT_T - 1) / SPLIT_T;
    {
        const int lane = tid & 63, wv = tid >> 6; const unsigned pa = (unsigned)parts, pb = parts > 1 ? (unsigned)parts : 0u;
        unsigned ia = pa, ib = pb;
#pragma unroll
        for (int o = 1; o < 64; o <<= 1) { const unsigned ta = __shfl_up(ia, o), tb = __shfl_up(ib, o); if (lane >= o) { ia += ta; ib += tb; } }
        if (lane == 63) { sc[16 + wv] = ia; sc[32 + wv] = ib; }
        __syncthreads();
        unsigned oa = 0, ob = 0, ta_ = 0, tb_ = 0;
#pragma unroll
        for (int w = 0; w < 8; ++w) { const unsigned xa = sc[16 + w], xb = sc[32 + w]; if (w < wv) { oa += xa; ob += xb; } ta_ += xa; tb_ += xb; }
        sc[64 + tid] = oa + ia - pa; sc[1024 + tid] = ob + ib - pb;
        if (tid == 0) { sc[2] = ta_; sc[3] = tb_; }
        __syncthreads();
    }
    const int u0 = (int)sc[64 + tid], s0 = (int)sc[1024 + tid], U = (int)sc[2];
    for (int pp = 0; pp < parts; ++pp) { const int a = jlo + (int)((long)n * pp / parts), b2 = jlo + (int)((long)n * (pp + 1) / parts);
        if (u0 + pp < MAX_UNITS) { tab[u0 + pp] = (u32x4){(unsigned)h | ((unsigned)qb << 16), (unsigned)a | ((unsigned)(b2 - a) << 16), (unsigned)pp | ((unsigned)parts << 16), (unsigned)(s0 + pp)};
            cost[u0 + pp] = (unsigned short)(b2 - a); } }
    __syncthreads();
    const int Uc = U < MAX_UNITS ? U : MAX_UNITS;
    for (int i = Uc + tid; i < ((Uc + 7) & ~7); i += NT) cost[i] = 0;
    __syncthreads();
    for (int i = tid; i < Uc; i += NT) { const unsigned ci = cost[i]; int rk = 0;
        for (int j8 = 0; j8 < Uc; j8 += 8) { const u32x4 c4 = *(const LAS u32x4*)(cost + j8); const unsigned cw[4] = {c4.x, c4.y, c4.z, c4.w};
#pragma unroll
            for (int e = 0; e < 8; ++e) { const unsigned cj = (cw[e >> 1] >> (16 * (e & 1))) & 0xffffu; const int j = j8 + e; rk += (cj > ci || (cj == ci && j < i)) ? 1 : 0; } }
        order[rk] = (unsigned short)i; }
    __syncthreads();
    return Uc;
}
__device__ __forceinline__ BlockRef unit_ref(const LAS unsigned char* lds, int ticket) {
    const LAS u32x4* tab = (const LAS u32x4*)lds; const LAS unsigned short* order = (const LAS unsigned short*)(lds + 16384);
    const u32x4 u = tab[order[ticket]];
    BlockRef r; r.h = (int)(u.x & 0xffffu); r.qb = (int)(u.x >> 16); r.j0 = (int)(u.y & 0xffffu); r.NT = (int)(u.y >> 16); r.slot = (u.z >> 16) > 1u ? (int)u.w : -1;
    r.h = __builtin_amdgcn_readfirstlane(r.h); r.qb = __builtin_amdgcn_readfirstlane(r.qb); r.j0 = __builtin_amdgcn_readfirstlane(r.j0); r.NT = __builtin_amdgcn_readfirstlane(r.NT); r.slot = __builtin_amdgcn_readfirstlane(r.slot);
    return r;
}
constexpr int TAB_OFF = 69632;
__device__ __forceinline__ int att_phase(int& U_out, char* lds_g, LAS unsigned char* lds, const f16_t* Q, const f16_t* K, const f16_t* V, f16_t* O, const unsigned long long* M, unsigned char* PART,
                                          const unsigned* NEED, unsigned* qhead, unsigned* UT, int bx, int tid, int wid) {
    const int U = build_units(lds + TAB_OFF, NEED, tid);
    if (bx == 0) { const LAS unsigned* t32 = (const LAS unsigned*)(lds + TAB_OFF);
        for (int i = tid; i < U * 4; i += NT) UT[4 + i] = t32[i];
        if (tid == 0) UT[0] = (unsigned)U; }
    LAS unsigned* tk = (LAS unsigned*)(lds + TAB_OFF + 24576 + 2048);
    if (tid == 0) { tk[0] = __hip_atomic_fetch_add(qhead, 1u, __ATOMIC_RELAXED, __HIP_MEMORY_SCOPE_AGENT); }
    __syncthreads();
    int ticket = (int)tk[0];
    U_out = U;
    if (ticket >= U) return ticket;
    const Ptrs P{Q, K, V, O, M, PART};
    BlockRef cur = unit_ref(lds + TAB_OFF, ticket);
    Seam S;
    att_prime(cur, P, lds_g, S, wid);
    int pend;
    for (;;) {
        if (wid == 0 && lane_id() == 0) tk[1] = __hip_atomic_fetch_add(qhead, 1u, __ATOMIC_RELAXED, __HIP_MEMORY_SCOPE_AGENT);
        __syncthreads();
        const int tn = (int)tk[1]; const bool last = tn >= U;
        const BlockRef nxt = last ? cur : unit_ref(lds + TAB_OFF, tn);
        att_block(cur, nxt, P, lds_g, S, wid);
        if (last) { pend = tn; break; }
        cur = nxt;
    }
    return pend;
}
__device__ __forceinline__ void att_combine(LAS unsigned char* lds, const unsigned* UT, const unsigned char* PART, f16_t* O, int gw, int ngw, int lane, int tid) {
    const int U = (int)UT[0]; constexpr float C2 = 1.4426950408889634f * SCALE;
    LAS u32x4* tab = (LAS u32x4*)lds;
    for (int i = tid; i < U; i += NT) tab[i] = *(const u32x4*)(UT + 4 + 4 * i);
    LDS_WAIT(); __syncthreads();
    int base = 0;
    for (int ui = 0; ui < U; ++ui) { const u32x4 u = tab[ui];
        const int h = (int)(u.x & 0xffffu), qb = (int)(u.x >> 16), part = (int)(u.z & 0xffffu), nparts = (int)(u.z >> 16), slot = (int)u.w;
        if (nparts <= 1 || part != 0) continue;
        for (int row = ((gw - base) % ngw + ngw) % ngw; row < QB; row += ngw) {
            float mm[3], ll[3]; h16x2 vv[3];
#pragma unroll
            for (int pp = 0; pp < 3; ++pp) { const int pq = pp < nparts ? pp : 0; const unsigned char* bs = PART + (size_t)(slot + pq) * (PART_O_BYTES + PART_ML_BYTES); const f32x2 ml = *(const f32x2*)((const float*)(bs + PART_O_BYTES) + row * 2);
                mm[pp] = pp < nparts ? ml.x : -3.0e38f; ll[pp] = pp < nparts ? ml.y : 0.f; vv[pp] = *(const h16x2*)((const f16_t*)bs + (size_t)row * D + 2 * lane); }
            const float Mx = fmaxf(fmaxf(mm[0], mm[1]), mm[2]);
            float a0 = 0.f, a1 = 0.f, lsum = 0.f;
#pragma unroll
            for (int pp = 0; pp < 3; ++pp) { const float w = __builtin_amdgcn_exp2f((mm[pp] - Mx) * C2) * ll[pp]; a0 = fmaf(w, (float)vv[pp][0], a0); a1 = fmaf(w, (float)vv[pp][1], a1); lsum += w; }
            const float rl = 1.0f / lsum;
            if (MIX_F8) { const float c0 = a0 * rl, c1 = a1 * rl, c2 = __shfl_xor(c0, 1), c3 = __shfl_xor(c1, 1);
                if ((lane & 1) == 0) *(unsigned*)((unsigned char*)O + (size_t)(qb * QB + row) * ASTR + h * D + 2 * lane) = pk_f8x4(c0, c1, c2, c3); }
            else *(unsigned*)(O + (size_t)(qb * QB + row) * ASTR + h * D + 2 * lane) = pk_h2(a0 * rl, a1 * rl); }
        base += QB; }
    __syncthreads();
}
}


__device__ __forceinline__ const float* argp(int i) { const char __attribute__((address_space(4)))* k = (const char __attribute__((address_space(4)))*)__builtin_amdgcn_kernarg_segment_ptr(); asm volatile("" : "+s"(k)); return *(const float* const __attribute__((address_space(4)))*)(k + i * 8); }
namespace idx {
__device__ __forceinline__ float relu_i(float x) { return __int_as_float(max(__float_as_int(x), 0)); }
constexpr int CAPX = 512;
constexpr int BROW = 514;
constexpr int L_BITS = 0, L_HIST = 66048, L_KST = 98816, L_ST = 115200, L_W = 117248;
constexpr int ST_LO = 0, ST_INV = 32, ST_THR1 = 64, ST_ABOVE = 128, ST_SUM = 192, ST_SQ = 224, ST_BEST = 264, ST_NEED = 296, ST_WORDS = 304;
__host__ __device__ __forceinline__ size_t bins_off(int u) { const size_t M = (size_t)(u >> 3); return (size_t)8192 * (4 * M * (M + 1) + (size_t)(u & 7) * (M + 1)); }
constexpr size_t BINS_BYTES = (size_t)8192 * (4 * 64 * 65);
template <int MODE>
__device__ __forceinline__ void pass(LAS unsigned char* lds, const f16_t* KI, unsigned char* bins, int RS, int q0, int nkt, const h16x8 (&afr)[4][4], const h16x8 (&wh)[4][2], int wave, int lane) {
    LAS unsigned* hist = (LAS unsigned*)(lds + L_HIST); LAS float* stf = (LAS float*)(lds + L_ST);
    const int pg = wave & 3, kh = wave >> 2, n = lane & 31, hi = lane >> 5;
    const int key_l = 32 * kh + n, hbase = (8 * pg + hi) * 256;
    const unsigned boff = (unsigned)((8 * pg + hi) * RS + 4 * key_l);
    const unsigned koff = (unsigned)(key_l * IDIM + hi * 8) * 2u;
    h16x8 bn[4];
#pragma unroll
    for (int ks = 0; ks < 4; ++ks) bn[ks] = *(const h16x8*)((const char*)KI + (size_t)(ks * 32) + koff);
    unsigned bw[4] = {0u, 0u, 0u, 0u};
    float cinv[4] = {0.f, 0.f, 0.f, 0.f}, cnlo[4] = {0.f, 0.f, 0.f, 0.f};
    if (MODE == 1) {
#pragma unroll
        for (int p = 0; p < 4; ++p) { const int ql = 8 * pg + 2 * p + hi; cinv[p] = stf[ST_INV + ql]; cnlo[p] = -stf[ST_LO + ql] * cinv[p]; } }
#pragma unroll 1
    for (int kt = 0; kt < nkt; ++kt) {
        h16x8 bfr[4];
#pragma unroll
        for (int ks = 0; ks < 4; ++ks) bfr[ks] = bn[ks];
        const int key = 64 * kt + key_l;
        f32x16 acc_c = {};
#pragma unroll
        for (int ks = 0; ks < 4; ++ks) acc_c = __builtin_amdgcn_mfma_f32_32x32x16_f16(afr[0][ks], bfr[ks], acc_c, 0, 0, 0);
        __builtin_amdgcn_sched_barrier(0);
        if (MODE == 1 && kt > 0 && (kt & 3) == 0) {
#pragma unroll
            for (int p = 0; p < 4; ++p) { *(unsigned*)(bins + (size_t)(2 * p * RS + 256 * ((kt >> 2) - 1)) + boff) = bw[p]; bw[p] = 0u; } }
        if (kt + 1 < nkt) {
#pragma unroll
            for (int ks = 0; ks < 4; ++ks) bn[ks] = *(const h16x8*)((const char*)KI + (size_t)((kt + 1) * 8192 + ks * 32) + koff); }
        __builtin_amdgcn_sched_barrier(0);
#pragma unroll
        for (int p = 0; p < 4; ++p) {
            f32x16 acc_n = {};
            if (p < 3) {
#pragma unroll
                for (int ks = 0; ks < 4; ++ks) acc_n = __builtin_amdgcn_mfma_f32_32x32x16_f16(afr[p < 3 ? p + 1 : 3][ks], bfr[ks], acc_n, 0, 0, 0); }
            h16x8 rb0, rb1;
#pragma unroll
            for (int j = 0; j < 8; j += 2) { const f32x2 a01 = {acc_c[j], acc_c[j + 1]}, b01 = {acc_c[8 + j], acc_c[8 + j + 1]};
                const h16x2 ha = __builtin_convertvector(a01, h16x2), hb = __builtin_convertvector(b01, h16x2);
                rb0[j] = ha[0]; rb0[j + 1] = ha[1]; rb1[j] = hb[0]; rb1[j + 1] = hb[1]; }
            { const h16x8 z8 = {0, 0, 0, 0, 0, 0, 0, 0}, o8 = {1, 1, 1, 1, 1, 1, 1, 1}; rb0 = __builtin_elementwise_min(__builtin_elementwise_max(rb0, z8), o8); rb1 = __builtin_elementwise_min(__builtin_elementwise_max(rb1, z8), o8); }
            f32x4 yy = {0.f, 0.f, 0.f, 0.f};
            yy = __builtin_amdgcn_mfma_f32_16x16x32_f16(wh[p][0], rb0, yy, 0, 0, 0);
            yy = __builtin_amdgcn_mfma_f32_16x16x32_f16(wh[p][1], rb1, yy, 0, 0, 0);
            const float score = yy[0];
            const int ql = 8 * pg + 2 * p + hi;
            if (MODE == 0) {
                float s1 = score, s2 = score * score;
#pragma unroll
                for (int o = 1; o < 32; o <<= 1) { s1 += __shfl_xor(s1, o); s2 += __shfl_xor(s2, o); }
                if (n == 0) { __hip_atomic_fetch_add(stf + ST_SUM + ql, s1, __ATOMIC_RELAXED, __HIP_MEMORY_SCOPE_WORKGROUP); __hip_atomic_fetch_add(stf + ST_SQ + ql, s2, __ATOMIC_RELAXED, __HIP_MEMORY_SCOPE_WORKGROUP); }
            } else {
                const int b1 = (int)__builtin_amdgcn_fmed3f(fmaf(score, cinv[p], cnlo[p]), 0.f, 255.f);
                const unsigned valid = key <= q0 + ql ? 1u : 0u;
                __hip_atomic_fetch_add(hist + (hbase + b1) + p * 512, valid, __ATOMIC_RELAXED, __HIP_MEMORY_SCOPE_WORKGROUP);
                bw[p] |= (unsigned)b1 << (8 * (kt & 3));
            }
            acc_c = acc_n;
        }
    }
    if (MODE == 1) {
#pragma unroll
        for (int p = 0; p < 4; ++p) *(unsigned*)(bins + (size_t)(2 * p * RS + 256 * ((nkt - 1) >> 2)) + boff) = bw[p]; }
}
__device__ __forceinline__ void pass_pp(LAS unsigned char* lds, const f16_t* KI, unsigned char* bins, int RS, int q0, int nkt, const h16x8 (&afr)[4][4], const h16x8 (&wh)[4][2], int wave, int lane) {
    LAS unsigned* hist = (LAS unsigned*)(lds + L_HIST); LAS float* stf = (LAS float*)(lds + L_ST);
    const int pg = wave & 3, kh = wave >> 2, n = lane & 31, hi = lane >> 5;
    const int key_l = 32 * kh + n, hbase = (8 * pg + hi) * 256;
    const unsigned boff = (unsigned)((8 * pg + hi) * RS + 4 * key_l);
    const unsigned koff = (unsigned)(key_l * IDIM + hi * 8) * 2u;
    h16x8 bA[4], bB[4];
    { const int t1 = nkt > 1 ? 1 : 0;
#pragma unroll
      for (int ks = 0; ks < 4; ++ks) { bA[ks] = *(const h16x8*)((const char*)KI + (size_t)(ks * 32) + koff); bB[ks] = *(const h16x8*)((const char*)KI + (size_t)(t1 * 8192 + ks * 32) + koff); } }
    unsigned bw[4] = {0u, 0u, 0u, 0u};
    float cinv[4], cnlo[4];
#pragma unroll
    for (int p = 0; p < 4; ++p) { const int ql = 8 * pg + 2 * p + hi; cinv[p] = stf[ST_INV + ql]; cnlo[p] = -stf[ST_LO + ql] * cinv[p]; }
    h16x8 rb[4][2]; float sc[4];
#pragma unroll
    for (int p = 0; p < 4; ++p) { rb[p][0] = afr[p][0]; rb[p][1] = afr[p][1]; }
#define IDX_HS() do { _Pragma("unroll") for (int p = 0; p < 4; ++p) { f32x4 yy = {0.f, 0.f, 0.f, 0.f}; \
        yy = __builtin_amdgcn_mfma_f32_16x16x32_f16(wh[p][0], rb[p][0], yy, 0, 0, 0); yy = __builtin_amdgcn_mfma_f32_16x16x32_f16(wh[p][1], rb[p][1], yy, 0, 0, 0); sc[p] = yy[0]; } } while (0)
#define IDX_TAIL(KT) do { const int kq_ = (KT); const int key = 64 * kq_ + key_l; \
        _Pragma("unroll") for (int p = 0; p < 4; ++p) { const int ql = 8 * pg + 2 * p + hi; \
            const int b1 = (int)__builtin_amdgcn_fmed3f(fmaf(sc[p], cinv[p], cnlo[p]), 0.f, 255.f); \
            const unsigned valid = key <= q0 + ql ? 1u : 0u; \
            __hip_atomic_fetch_add(hist + (hbase + b1) + p * 512, valid, __ATOMIC_RELAXED, __HIP_MEMORY_SCOPE_WORKGROUP); \
            bw[p] |= (unsigned)b1 << (8 * (kq_ & 3)); } } while (0)
    if (kh == 1) __builtin_amdgcn_s_barrier();
#pragma unroll 1
    for (int kt2 = 0; kt2 < nkt; kt2 += 2) {
        {
        IDX_HS();
        f32x16 acc[4];
#pragma unroll
        for (int p = 0; p < 4; ++p)
#pragma unroll
            for (int ks = 0; ks < 4; ++ks) acc[p] = __builtin_amdgcn_mfma_f32_32x32x16_f16(afr[p][ks], bA[ks], ks == 0 ? (f32x16){} : acc[p], 0, 0, 0);
        __builtin_amdgcn_sched_barrier(0);
        __builtin_amdgcn_s_barrier();
        __builtin_amdgcn_sched_barrier(0);
        if ((kt2) >= 5 && (((kt2) - 1) & 3) == 0) {
#pragma unroll
            for (int p = 0; p < 4; ++p) { *(unsigned*)(bins + (size_t)(2 * p * RS + 256 * (((kt2) - 5) >> 2)) + boff) = bw[p]; bw[p] = 0u; } }
        { const int tl = (kt2) + 2 < nkt ? (kt2) + 2 : nkt - 1;
#pragma unroll
            for (int ks = 0; ks < 4; ++ks) bA[ks] = *(const h16x8*)((const char*)KI + (size_t)(tl * 8192 + ks * 32) + koff); }
        __builtin_amdgcn_sched_barrier(0);
        if ((kt2) > 0) IDX_TAIL((kt2) - 1);
#pragma unroll
        for (int p = 0; p < 4; ++p) {
            h16x8 r0, r1;
#pragma unroll
            for (int j = 0; j < 8; j += 2) { const f32x2 a01 = {acc[p][j], acc[p][j + 1]}, b01 = {acc[p][8 + j], acc[p][8 + j + 1]};
                const h16x2 ha = __builtin_convertvector(a01, h16x2), hb = __builtin_convertvector(b01, h16x2);
                r0[j] = ha[0]; r0[j + 1] = ha[1]; r1[j] = hb[0]; r1[j + 1] = hb[1]; }
            { const h16x8 z8 = {0, 0, 0, 0, 0, 0, 0, 0}, o8 = {1, 1, 1, 1, 1, 1, 1, 1}; r0 = __builtin_elementwise_min(__builtin_elementwise_max(r0, z8), o8); r1 = __builtin_elementwise_min(__builtin_elementwise_max(r1, z8), o8); }
            rb[p][0] = r0; rb[p][1] = r1; }
        __builtin_amdgcn_sched_barrier(0);
        __builtin_amdgcn_s_barrier();
        __builtin_amdgcn_sched_barrier(0);
        }
        if (kt2 + 1 < nkt) {
        IDX_HS();
        f32x16 acc[4];
#pragma unroll
        for (int p = 0; p < 4; ++p)
#pragma unroll
            for (int ks = 0; ks < 4; ++ks) acc[p] = __builtin_amdgcn_mfma_f32_32x32x16_f16(afr[p][ks], bB[ks], ks == 0 ? (f32x16){} : acc[p], 0, 0, 0);
        __builtin_amdgcn_sched_barrier(0);
        __builtin_amdgcn_s_barrier();
        __builtin_amdgcn_sched_barrier(0);
        if ((kt2 + 1) >= 5 && (((kt2 + 1) - 1) & 3) == 0) {
#pragma unroll
            for (int p = 0; p < 4; ++p) { *(unsigned*)(bins + (size_t)(2 * p * RS + 256 * (((kt2 + 1) - 5) >> 2)) + boff) = bw[p]; bw[p] = 0u; } }
        { const int tl = (kt2 + 1) + 2 < nkt ? (kt2 + 1) + 2 : nkt - 1;
#pragma unroll
            for (int ks = 0; ks < 4; ++ks) bB[ks] = *(const h16x8*)((const char*)KI + (size_t)(tl * 8192 + ks * 32) + koff); }
        __builtin_amdgcn_sched_barrier(0);
        if ((kt2 + 1) > 0) IDX_TAIL((kt2 + 1) - 1);
#pragma unroll
        for (int p = 0; p < 4; ++p) {
            h16x8 r0, r1;
#pragma unroll
            for (int j = 0; j < 8; j += 2) { const f32x2 a01 = {acc[p][j], acc[p][j + 1]}, b01 = {acc[p][8 + j], acc[p][8 + j + 1]};
                const h16x2 ha = __builtin_convertvector(a01, h16x2), hb = __builtin_convertvector(b01, h16x2);
                r0[j] = ha[0]; r0[j + 1] = ha[1]; r1[j] = hb[0]; r1[j + 1] = hb[1]; }
            { const h16x8 z8 = {0, 0, 0, 0, 0, 0, 0, 0}, o8 = {1, 1, 1, 1, 1, 1, 1, 1}; r0 = __builtin_elementwise_min(__builtin_elementwise_max(r0, z8), o8); r1 = __builtin_elementwise_min(__builtin_elementwise_max(r1, z8), o8); }
            rb[p][0] = r0; rb[p][1] = r1; }
        __builtin_amdgcn_sched_barrier(0);
        __builtin_amdgcn_s_barrier();
        __builtin_amdgcn_sched_barrier(0);
        }
    }
    if (kh == 0) __builtin_amdgcn_s_barrier();
    IDX_HS();
    if (nkt > 1 && ((nkt - 1) & 3) == 0) {
#pragma unroll
        for (int p = 0; p < 4; ++p) { *(unsigned*)(bins + (size_t)(2 * p * RS + 256 * (((nkt - 1) >> 2) - 1)) + boff) = bw[p]; bw[p] = 0u; } }
    IDX_TAIL(nkt - 1);
#pragma unroll
    for (int p = 0; p < 4; ++p) *(unsigned*)(bins + (size_t)(2 * p * RS + 256 * ((nkt - 1) >> 2)) + boff) = bw[p];
#undef IDX_HS
#undef IDX_TAIL
}
__device__ __forceinline__ void scan_hist(const LAS unsigned* h, int need, int lane, int& thr, int& above, int& inbin) {
    const u32x4 c = *(const LAS u32x4*)(h + 4 * lane);
    const int s = (int)(c.x + c.y + c.z + c.w);
    int v = s;
#pragma unroll
    for (int o = 1; o < 64; o <<= 1) { const int t = __shfl_down(v, o); if (lane + o < 64) v += t; }
    int run = v - s;
    int mythr = -1, myab = 0, myin = 0;
    if (run < need && run + s >= need) {
        const int cc[4] = {(int)c.x, (int)c.y, (int)c.z, (int)c.w};
#pragma unroll
        for (int k = 3; k >= 0; --k) { if (mythr < 0 && run + cc[k] >= need) { mythr = 4 * lane + k; myab = run; myin = cc[k]; } run += cc[k]; }
    }
    const unsigned long long bal = __ballot(mythr >= 0);
    const int src = bal ? (int)__builtin_ctzll(bal) : 0;
    thr = __shfl(mythr, src); above = __shfl(myab, src); inbin = __shfl(myin, src);
    if (!bal) { thr = 0; above = 0; inbin = 0; }
}
__device__ __forceinline__ void resolve(LAS unsigned char* lds, const f16_t* QI, const f16_t* KI, const float* WI, unsigned long long* MASK, unsigned char* BINS, unsigned* NEED, int q0_, int tid, int wave, int lane);
__device__ __forceinline__ void unit(LAS unsigned char* lds, const f16_t* QI, const f16_t* KI, const float* WI, unsigned long long* MASK, unsigned char* BINS, unsigned* NEED, int q0, int tid, int wave, int lane) {
    LAS unsigned* bits = (LAS unsigned*)(lds + L_BITS); LAS unsigned* hist = (LAS unsigned*)(lds + L_HIST); LAS unsigned* st = (LAS unsigned*)(lds + L_ST);
    LAS float* stf = (LAS float*)(lds + L_ST);
    const int Q0 = q0 & ~255, ntile = (Q0 + 256) / 64;
    if (q0 < 256) {
        for (int i = tid; i < ntile * 32; i += NT) { const int j = i >> 5, ql = i & 31, t = q0 + ql; const int k0 = 64 * j;
            const unsigned long long w = t >= k0 + 63 ? ~0ull : (t < k0 ? 0ull : ((1ull << (t - k0 + 1)) - 1ull));
            MASK[(size_t)j * SEQ + q0 + ql] = w; }
        return;
    }
    __syncthreads();
    for (int i = tid; i < 32768 / 16; i += NT) ((LAS u32x4*)(lds + L_HIST))[i] = (u32x4){0u, 0u, 0u, 0u};
    if (tid < ST_WORDS) st[tid] = 0u;
    const int pg = wave & 3, r = lane & 31, hi2 = lane >> 5;
    h16x8 afr[4][4]; h16x8 wh[4][2];
#pragma unroll
    for (int p = 0; p < 4; ++p) { const int q = q0 + 8 * pg + 2 * p + (r >> 4);
#pragma unroll
        for (int ks = 0; ks < 4; ++ks) afr[p][ks] = *(const h16x8*)(QI + (size_t)q * 1024 + (r & 15) * 64 + ks * 16 + hi2 * 8) * (_Float16)0.00390625f;
#pragma unroll
        for (int e = 0; e < 2; ++e) { const int kq = lane >> 4, hb = kq >> 1;
            const float* wr = WI + (size_t)(q0 + 8 * pg + 2 * p + e) * IH + 4 * hb; const f32x4 wa = *(const f32x4*)wr, wb = *(const f32x4*)(wr + 8);
            const bool on = (lane & 15) == 8 * e + 4 * (kq & 1);
            wh[p][e] = on ? (h16x8){(_Float16)wa[0], (_Float16)wa[1], (_Float16)wa[2], (_Float16)wa[3], (_Float16)wb[0], (_Float16)wb[1], (_Float16)wb[2], (_Float16)wb[3]} : (h16x8){0, 0, 0, 0, 0, 0, 0, 0}; }
    }
    LDS_WAIT(); __syncthreads();
    const int nkt = q0 / 64 + 1, RS = Q0 + 256;
    unsigned char* bins = BINS + bins_off(q0 >> 5);
    pass<0>(lds, KI, bins, RS, q0, 1, afr, wh, wave, lane);
    LDS_WAIT(); __syncthreads();
    if (tid < 32) { const float mu = stf[ST_SUM + tid] * (1.0f / 64), var = fmaxf(stf[ST_SQ + tid] * (1.0f / 64) - mu * mu, 1e-20f), sd = sqrtf(var);
        stf[ST_LO + tid] = mu - 4.0f * sd; stf[ST_INV + tid] = 25.6f / sd; }
    LDS_WAIT(); __syncthreads();
    pass_pp(lds, KI, bins, RS, q0, nkt, afr, wh, wave, lane);
    asm volatile("s_waitcnt vmcnt(0) lgkmcnt(0)" ::: "memory"); __syncthreads();
#pragma unroll 1
    for (int i = 0; i < 4; ++i) { const int ql = 4 * wave + i; int thr, above, inbin; scan_hist(hist + ql * 256, TOPK, lane, thr, above, inbin);
        if (lane == 0) { st[ST_THR1 + ql] = (unsigned)thr; st[ST_ABOVE + ql] = (unsigned)above; } }
    LDS_WAIT(); __syncthreads();
    resolve(lds, QI, KI, WI, MASK, BINS, NEED, q0, tid, wave, lane);
}
__device__ __forceinline__ void resolve(LAS unsigned char* lds, const f16_t* QI, const f16_t* KI, const float* WI, unsigned long long* MASK, unsigned char* BINS, unsigned* NEED, int q0_, int tid, int wave, int lane) {
    int q0 = q0_; asm volatile("" : "+s"(q0));
    LAS unsigned* bits = (LAS unsigned*)(lds + L_BITS); LAS unsigned* st = (LAS unsigned*)(lds + L_ST);
    const int Q0 = q0 & ~255, ntile = (Q0 + 256) / 64, RS = Q0 + 256;
    unsigned char* bins = BINS + bins_off(q0 >> 5);
    LAS unsigned* candk = (LAS unsigned*)(lds + L_HIST + wave * 4096); LAS float* cands = (LAS float*)(candk + CAPX);
    const int h = lane & 15;
#pragma unroll 1
    for (int i = 0; i < 4; ++i) { const int ql = 4 * wave + i, t = q0 + ql; const int thr = (int)st[ST_THR1 + ql], need = TOPK - (int)st[ST_ABOVE + ql];
        const unsigned* row = (const unsigned*)(bins + (size_t)ql * RS);
        int cnt = 0;
        const int ngrp = RS >> 8;
        const unsigned thrw = (unsigned)thr * 0x01010101u;
        const int nfull = ngrp - 1;
        for (int g0 = 0; g0 < nfull; g0 += 16) {
            unsigned wv[16];
#pragma unroll
            for (int u8 = 0; u8 < 16; ++u8) { const int gc = min(g0 + u8, nfull - 1); wv[u8] = row[gc * 64 + lane]; }
            unsigned accA = 0u, accB = 0u;
#pragma unroll
            for (int u8 = 0; u8 < 16; ++u8) { const int gi = g0 + u8; if (gi < nfull) { const unsigned w = wv[u8];
                const unsigned x = w ^ thrw; const bool hasc = ((x - 0x01010101u) & ~x & 0x80808080u) != 0u;
                const bool anyc = __builtin_amdgcn_ballot_w64(hasc) != 0ull;
#pragma unroll
                for (int b = 0; b < 4; ++b) { const int v = (int)((w >> (8 * b)) & 255u);
                    const unsigned long long m = __builtin_amdgcn_ballot_w64(v > thr);
                    const int mi = 4 * u8 + b;
                    const unsigned mlo = (unsigned)m, mhi = (unsigned)(m >> 32);
                    if (mi < 32) asm volatile("s_nop 4\n\tv_writelane_b32 %0, %1, %3\n\ts_nop 1\n\tv_writelane_b32 %0, %2, %4" : "+v"(accA) : "s"(mlo), "s"(mhi), "n"(2 * (mi & 31)), "n"(2 * (mi & 31) + 1));
                    else asm volatile("s_nop 4\n\tv_writelane_b32 %0, %1, %3\n\ts_nop 1\n\tv_writelane_b32 %0, %2, %4" : "+v"(accB) : "s"(mlo), "s"(mhi), "n"(2 * (mi & 31)), "n"(2 * (mi & 31) + 1));
                    if (anyc) { const unsigned long long cm = __builtin_amdgcn_ballot_w64(v == thr);
                        if (cm) { const int pre = (int)__builtin_popcountll(cm & ((1ull << lane) - 1ull));
                            if (v == thr && cnt + pre < CAPX) candk[cnt + pre] = (unsigned)(256 * gi + 64 * b + lane);
                            cnt += (int)__builtin_popcountll(cm); } } } } }
            bits[ql * BROW + 8 * g0 + lane] = accA; bits[ql * BROW + 8 * g0 + 64 + lane] = accB; }
        {
            const int gi = nfull; const unsigned w = row[gi * 64 + lane];
#pragma unroll
            for (int b = 0; b < 4; ++b) { const int v = (int)((w >> (8 * b)) & 255u), key = 256 * gi + 64 * b + lane; const bool valid = key <= t;
                const unsigned long long m = __ballot(valid && v > thr);
                if (lane == 0) *(LAS unsigned long long*)(bits + ql * BROW + 2 * (4 * gi + b)) = m;
                const unsigned long long cm = __ballot(valid && v == thr);
                if (cm) { const int pre = (int)__builtin_popcountll(cm & ((1ull << lane) - 1ull));
                    if (valid && v == thr && cnt + pre < CAPX) candk[cnt + pre] = (unsigned)key;
                    cnt += (int)__builtin_popcountll(cm); } } }
        cnt = min(cnt, CAPX);
        LDS_WAIT();
        { const int n16 = lane & 15, kq = lane >> 4;
          const h16x8 qa0 = *(const h16x8*)(QI + (size_t)t * 1024 + n16 * 64 + 8 * kq), qa1 = *(const h16x8*)(QI + (size_t)t * 1024 + n16 * 64 + 32 + 8 * kq);
          const f32x4 w4 = *(const f32x4*)(WI + (size_t)t * IH + 4 * kq);
          for (int e0 = 0; e0 < cnt; e0 += 16) { const int e = min(e0 + n16, cnt - 1); const unsigned key = candk[e];
              const h16x8 kb0 = *(const h16x8*)(KI + (size_t)key * IDIM + 8 * kq), kb1 = *(const h16x8*)(KI + (size_t)key * IDIM + 32 + 8 * kq);
              f32x4 dd = {0.f, 0.f, 0.f, 0.f};
              dd = __builtin_amdgcn_mfma_f32_16x16x32_f16(qa0, kb0, dd, 0, 0, 0);
              dd = __builtin_amdgcn_mfma_f32_16x16x32_f16(qa1, kb1, dd, 0, 0, 0);
              float sc2 = fmaxf(dd[0], 0.f) * w4[0] + fmaxf(dd[1], 0.f) * w4[1] + fmaxf(dd[2], 0.f) * w4[2] + fmaxf(dd[3], 0.f) * w4[3];
              sc2 += __shfl_xor(sc2, 16); sc2 += __shfl_xor(sc2, 32);
              if (kq == 0 && e0 + n16 < cnt) cands[e0 + n16] = sc2; } }
        LDS_WAIT();
        for (int e0 = 0; e0 < cnt; e0 += 64) { const int e = e0 + lane; const bool act = e < cnt; const float s0 = act ? cands[e] : 0.f; const unsigned k0 = act ? candk[e] : 0u;
            int rk = 0;
            for (int f = 0; f < cnt; ++f) { const float sf = cands[f]; const unsigned kf = candk[f]; rk += (sf > s0 || (sf == s0 && kf < k0)) ? 1 : 0; }
            if (act && rk < need) __hip_atomic_fetch_or(bits + ql * BROW + (k0 >> 5), 1u << (k0 & 31), __ATOMIC_RELAXED, __HIP_MEMORY_SCOPE_WORKGROUP); }
        LDS_WAIT();
        {
            int best = 0;
#pragma unroll
            for (int k = 0; k < 4; ++k) { const int j = lane + 64 * k; if (j < ntile) { const unsigned long long w = *(const LAS unsigned long long*)(bits + ql * BROW + 2 * j); if (w) best = max(best, 64 * j + 63 - (int)__builtin_clzll(w)); } }
#pragma unroll
            for (int o = 1; o < 64; o <<= 1) best = max(best, __shfl_xor(best, o));
            if (lane == 0) st[ST_BEST + ql] = (unsigned)best; }
    }
    LDS_WAIT(); __syncthreads();
    {
        const int ln = lane_id(), hh = ln >> 3, sub = ln & 7;
    const f16_t* QN = QI - (size_t)3 * SEQ * 1024; const f16_t* KN = QI - (size_t)2 * SEQ * 1024;
    const float* g_q = argp(13); const float* g_k = argp(14);
    float Bq;
    { const int l5 = ln & 31;
      float a = fmaxf(fmaxf(fabsf(g_q[l5]), fabsf(g_q[l5 + 32])), fmaxf(fabsf(g_q[l5 + 64]), fabsf(g_q[l5 + 96]))), b = fmaxf(fmaxf(fabsf(g_k[l5]), fabsf(g_k[l5 + 32])), fmaxf(fabsf(g_k[l5 + 64]), fabsf(g_k[l5 + 96])));
      a = fmaxf(a, swz_xor<1>(a)); b = fmaxf(b, swz_xor<1>(b)); a = fmaxf(a, swz_xor<2>(a)); b = fmaxf(b, swz_xor<2>(b)); a = fmaxf(a, swz_xor<4>(a)); b = fmaxf(b, swz_xor<4>(b));
      a = fmaxf(a, swz_xor<8>(a)); b = fmaxf(b, swz_xor<8>(b)); a = fmaxf(a, swz_xor<16>(a)); b = fmaxf(b, swz_xor<16>(b));
      Bq = 11.3137085f * 1.004f * a * b; }
        h16x8 qa[4], qb[4], ka[4], kb[4]; int bst[4];
#pragma unroll
        for (int i = 0; i < 4; ++i) { const int ql = 4 * wave + i, t = q0 + ql; bst[i] = (int)st[ST_BEST + ql];
            const size_t qo = (size_t)t * 1024 + hh * 128 + sub * 16, ko = (size_t)bst[i] * 1024 + hh * 128 + sub * 16;
            qa[i] = *(const h16x8*)(QN + qo); qb[i] = *(const h16x8*)(QN + qo + 8); ka[i] = *(const h16x8*)(KN + ko); kb[i] = *(const h16x8*)(KN + ko + 8); }
        int need = 0;
#pragma unroll
        for (int i = 0; i < 4; ++i) { const int t = q0 + 4 * wave + i; float dot = 0.f;
#pragma unroll
            for (int j = 0; j < 8; ++j) { dot = fmaf((float)qa[i][j], (float)ka[i][j], dot); dot = fmaf((float)qb[i][j], (float)kb[i][j], dot); }
            dot += swz_xor<1>(dot); dot += swz_xor<2>(dot); dot += swz_xor<4>(dot);
            const float wdw = (float)(t - bst[i]) + (Bq - dot * att::SCALE + att::MARGIN + 0.05f) * (float)(2 << hh);
            need = max(need, (int)ceilf(wdw) - (t - Q0)); }
        if (sub == 0) __hip_atomic_fetch_max(st + ST_NEED + hh, (unsigned)need, __ATOMIC_RELAXED, __HIP_MEMORY_SCOPE_WORKGROUP);
    }
    for (int i = tid; i < ntile * 32; i += NT) { const int j = i >> 5, ql = i & 31;
        const unsigned lo = bits[ql * BROW + 2 * j], hi = bits[ql * BROW + 2 * j + 1];
        MASK[(size_t)j * SEQ + q0 + ql] = ((unsigned long long)hi << 32) | lo; }
    LDS_WAIT(); __syncthreads();
    if (tid < 8) __hip_atomic_fetch_max(NEED + (q0 >> 8) * 8 + tid, st[ST_NEED + tid], __ATOMIC_RELAXED, __HIP_MEMORY_SCOPE_AGENT);
}
}

constexpr size_t MiB = 1u << 20;
constexpr size_t WS_CTL = 0, CTL_ZERO_BYTES = 1 * MiB;
constexpr size_t WS_ADAP = 1 * MiB;
constexpr size_t WS_ADA = 3 * MiB;
constexpr size_t WS_WFF = 4 * MiB;
constexpr size_t WS_WFFD = WS_WFF + (size_t)2 * DFF * DM * 2;
constexpr size_t WS_WIN = 70 * MiB;
constexpr size_t WS_WA = 556 * MiB, WS_WB = 560 * MiB, WS_WO = 564 * MiB;
constexpr size_t WS_NB = 128 * MiB;
constexpr size_t WS_HB = 192 * MiB;
constexpr size_t WS_Z6 = 192 * MiB;
constexpr size_t WS_GAB = 384 * MiB;
constexpr size_t WS_KI = 520 * MiB;
constexpr size_t WS_WI = 522 * MiB;
constexpr size_t WS_MASK = 524 * MiB;
constexpr size_t WS_X1H = 572 * MiB;
constexpr size_t WS_END = 636 * MiB;
constexpr size_t WS_A8 = 112 * MiB;
constexpr size_t WS_BINS = 4 * MiB;
static_assert(WS_BINS + idx::BINS_BYTES <= 192 * MiB, "bins");
static_assert(WS_WFFD + (size_t)DM * DFF * 2 <= WS_WIN && WS_WIN + (size_t)INW_PAD * DM * 2 <= 128 * MiB && WS_HB + (size_t)SEQ * DFF * 2 <= WS_GAB, "ws map");

constexpr int LDS_BYTES = 160 * 1024;
constexpr int LDS_MISC = LDS_BYTES - 256;

#define XB_TMO      128
#define XB_XCNT(j)  (256  + 64 * (j))
#define XB_XSUB(j)  (1280 + 64 * (j))
#define XB_XGEN(j)  (2304 + 64 * (j))
#define XB_TOP      3328
#define XB_TOPGEN   3392
#define XCD_BAR_WORDS 3456
#define XB_SPIN_CAP (1u << 18)
__device__ __forceinline__ unsigned xb_ld(unsigned* p)              { return __hip_atomic_load(p, __ATOMIC_RELAXED, __HIP_MEMORY_SCOPE_AGENT); }
__device__ __forceinline__ unsigned xb_add(unsigned* p, unsigned v) { return __hip_atomic_fetch_add(p, v, __ATOMIC_RELAXED, __HIP_MEMORY_SCOPE_AGENT); }
__device__ __forceinline__ unsigned xb_xcc_id() { return (unsigned)__builtin_amdgcn_s_getreg((3 << 11) | 20) & 0xFu; }
#define XB_SPIN(cond, bar) do { unsigned _sp = 0; while (cond) { __builtin_amdgcn_s_sleep(1); \
    if ((++_sp & 255u) == 0u) { if (xb_ld(&(bar)[XB_TMO])) break; if (_sp > XB_SPIN_CAP) { atomicAdd(&(bar)[XB_TMO], 1u); break; } } } } while (0)
struct XcdBarrier { unsigned* bar; unsigned x; volatile LAS unsigned* st; };
__device__ __forceinline__ XcdBarrier xcd_barrier_post(unsigned* bar, volatile LAS unsigned* st, bool t0) {
    XcdBarrier b; b.bar = bar; b.x = xb_xcc_id(); b.st = st;
    if (t0) (void)xb_add(&bar[XB_XCNT(b.x)], 1u);
    return b;
}
__device__ __forceinline__ void xcd_barrier_complete(unsigned* bar, unsigned x, unsigned& nloc, unsigned& nx) {
    const unsigned G = gridDim.x * gridDim.y * gridDim.z;
    unsigned sum, cnt, mine, sp = 0u;
    for (;;) {
        sum = 0u; cnt = 0u; mine = 0u;
#pragma unroll
        for (unsigned j = 0; j < 16; ++j) { const unsigned c = xb_ld(&bar[XB_XCNT(j)]); sum += c; cnt += (c > 0u) ? 1u : 0u; mine = (j == x) ? c : mine; }
        if (sum == G) break;
        __builtin_amdgcn_s_sleep(1);
        if ((++sp & 255u) == 0u) { if (xb_ld(&bar[XB_TMO])) break; if (sp > XB_SPIN_CAP) { atomicAdd(&bar[XB_TMO], 1u); break; } }
    }
    nloc = mine > 0u ? mine : 1u; nx = cnt > 0u ? cnt : 1u;
}
__device__ __forceinline__ void xcd_barrier(const XcdBarrier& b, bool t0) {
    asm volatile("s_waitcnt vmcnt(0)" ::: "memory");
    __syncthreads();
    if (t0) {
        unsigned* bar = b.bar;
        __builtin_amdgcn_s_waitcnt(0);
        unsigned nloc = b.st[0], nx = b.st[1];
        if (nloc == 0u) { xcd_barrier_complete(bar, b.x, nloc, nx); b.st[0] = nloc; b.st[1] = nx; }
        const unsigned old = xb_add(&bar[XB_XSUB(b.x)], 1u);
        const unsigned gen = old / nloc;
        if (old + 1u == (gen + 1u) * nloc) {
            __builtin_amdgcn_fence(__ATOMIC_RELEASE, "agent");
            asm volatile("s_waitcnt vmcnt(0)" ::: "memory");
            const unsigned og = xb_add(&bar[XB_TOP], 1u);
            const unsigned tg = og / nx;
            if (og + 1u == (tg + 1u) * nx) xb_add(&bar[XB_TOPGEN], 1u);
            else XB_SPIN(xb_ld(&bar[XB_TOPGEN]) == tg, bar);
            __builtin_amdgcn_fence(__ATOMIC_ACQUIRE, "agent");
            xb_add(&bar[XB_XGEN(b.x)], 1u);
            asm volatile("s_waitcnt vmcnt(0)" ::: "memory");
        } else {
            XB_SPIN(xb_ld(&bar[XB_XGEN(b.x)]) == gen, bar);
            __builtin_amdgcn_fence(__ATOMIC_ACQUIRE, "agent");
            asm volatile("s_waitcnt vmcnt(0)" ::: "memory");
        }
    }
    __syncthreads();
}

__device__ __forceinline__ float wave_sum(float v) {
#pragma unroll
    for (int o = 1; o < 64; o <<= 1) v += __shfl_xor(v, o);
    return v;
}

__device__ __forceinline__ void ada_partial(const float* c, const float* w_ada, float* part, int b, int tid) {
    if (b >= 256) return;
    const int s = b >> 4, cr = b & 15;
    if (tid < 288) {
        const float* wp = w_ada + (size_t)(s * 128) * NADA + cr * 1152 + tid * 4;
        f32x4 a = {0.f, 0.f, 0.f, 0.f};
#pragma unroll 32
        for (int i = 0; i < 128; ++i) { const float ci = c[s * 128 + i]; const float sc = silu_f(ci); const f32x4 w = *(const f32x4*)(wp + (size_t)i * NADA); a += w * sc; }
        *(f32x4*)(part + (size_t)s * NADA + cr * 1152 + tid * 4) = a;
    }
}
__device__ __forceinline__ float ada_col(const float* part, const float* b_ada, int col) {
    float a = b_ada[col];
#pragma unroll
    for (int s = 0; s < 16; ++s) a += part[(size_t)s * NADA + col];
    return a;
}

__device__ __forceinline__ void transpose_item(const float* W, int ldw, int K, int k0, int n_src0, int nv, f16_t* WT, int dst_row0, LAS float* scr, int lane) {
    const int cg = lane & 7, rr = lane >> 3;
#pragma unroll
    for (int it = 0; it < 8; ++it) { const int kk = it * 8 + rr; f32x4 v = {0.f, 0.f, 0.f, 0.f};
        const float* src = W + (size_t)(k0 + kk) * ldw + n_src0 + cg * 4;
        if (cg * 4 + 3 < nv) v = *(const f32x4*)src;
        else { if (cg * 4 + 0 < nv) v[0] = src[0]; if (cg * 4 + 1 < nv) v[1] = src[1]; if (cg * 4 + 2 < nv) v[2] = src[2]; }
        *(LAS f32x4*)(scr + kk * 36 + cg * 4) = v; }
    LDS_WAIT(); asm volatile("" ::: "memory");
    const int c = lane & 7;
#pragma unroll
    for (int j = 0; j < 4; ++j) { const int n = (lane >> 3) + 8 * j; const LAS float* s = scr + (8 * c) * 36 + n;
        u32x4 o; o.x = pk_h2(s[0 * 36], s[1 * 36]); o.y = pk_h2(s[2 * 36], s[3 * 36]); o.z = pk_h2(s[4 * 36], s[5 * 36]); o.w = pk_h2(s[6 * 36], s[7 * 36]);
        if (n < nv) *(u32x4*)(WT + (size_t)(dst_row0 + n) * K + k0 + 8 * c) = o; }
    LDS_WAIT(); asm volatile("" ::: "memory");
}
__device__ __forceinline__ void transpose_item_f8(const float* W, int ldw, int rowb, int k0, int n_src0, f8_t* WT, int dst_row0, float mul, LAS float* scr, int lane) {
    const int cg = lane & 7, rr = lane >> 3;
#pragma unroll
    for (int it = 0; it < 8; ++it) { const int kk = it * 8 + rr; *(LAS f32x4*)(scr + kk * 36 + cg * 4) = *(const f32x4*)(W + (size_t)(k0 + kk) * ldw + n_src0 + cg * 4); }
    LDS_WAIT(); asm volatile("" ::: "memory");
    const int n = lane >> 1, hf = lane & 1; const LAS float* sp = scr + (32 * hf) * 36 + n;
    u32x4 o0, o1;
    o0.x = pk_f8x4(sp[0 * 36] * mul, sp[1 * 36] * mul, sp[2 * 36] * mul, sp[3 * 36] * mul); o0.y = pk_f8x4(sp[4 * 36] * mul, sp[5 * 36] * mul, sp[6 * 36] * mul, sp[7 * 36] * mul);
    o0.z = pk_f8x4(sp[8 * 36] * mul, sp[9 * 36] * mul, sp[10 * 36] * mul, sp[11 * 36] * mul); o0.w = pk_f8x4(sp[12 * 36] * mul, sp[13 * 36] * mul, sp[14 * 36] * mul, sp[15 * 36] * mul);
    o1.x = pk_f8x4(sp[16 * 36] * mul, sp[17 * 36] * mul, sp[18 * 36] * mul, sp[19 * 36] * mul); o1.y = pk_f8x4(sp[20 * 36] * mul, sp[21 * 36] * mul, sp[22 * 36] * mul, sp[23 * 36] * mul);
    o1.z = pk_f8x4(sp[24 * 36] * mul, sp[25 * 36] * mul, sp[26 * 36] * mul, sp[27 * 36] * mul); o1.w = pk_f8x4(sp[28 * 36] * mul, sp[29 * 36] * mul, sp[30 * 36] * mul, sp[31 * 36] * mul);
    f8_t* dst = WT + (size_t)(dst_row0 + n) * rowb + k0 + 32 * hf;
    *(u32x4*)dst = o0; *(u32x4*)(dst + 16) = o1;
    LDS_WAIT(); asm volatile("" ::: "memory");
}
template <bool F8> __device__ __forceinline__ void convert_ffn_gu(const float* wg, const float* wu, void* Wt, LAS float* scr, int gw, int ngw, int lane) {
    constexpr int I_GU = (DM / 64) * (DFF / 32);
    for (int it = gw; it < 2 * I_GU; it += ngw) { const int which = it >= I_GU, r = it - which * I_GU, kb = r / (DFF / 32), nb = r % (DFF / 32), n0 = nb * 32;
        const int drow = 256 * (n0 / 128) + (n0 % 128) + which * 128;
        if (F8) transpose_item_f8(which ? wu : wg, DFF, DM, kb * 64, n0, (f8_t*)Wt, drow, W_GU_MUL, scr, lane);
        else transpose_item(which ? wu : wg, DFF, DM, kb * 64, n0, 32, (f16_t*)Wt, drow, scr, lane); }
}
template <bool F8> __device__ __forceinline__ void convert_ffn_d(const float* wd, void* Wd, LAS float* scr, int gw, int ngw, int lane) {
    constexpr int I_D = (DFF / 64) * (DM / 32);
    for (int it = gw; it < I_D; it += ngw) { const int kb = it / (DM / 32), nb = it % (DM / 32);
        if (F8) transpose_item_f8(wd, DM, DFF8, kb * 64, nb * 32, (f8_t*)Wd, nb * 32, W_D_MUL, scr, lane);
        else transpose_item(wd, DM, DFF, kb * 64, nb * 32, 32, (f16_t*)Wd, nb * 32, scr, lane); }
    if (F8) for (int r = gw; r < DM; r += ngw) if (lane < (DFF8 - DFF) / 16) *(u32x4*)((f8_t*)Wd + (size_t)r * DFF8 + DFF + 16 * lane) = (u32x4){0u, 0u, 0u, 0u};
}
template <bool F8> __device__ __forceinline__ void convert_down_in_tail(const float* wd, void* Wd, LAS unsigned char* lds, int bx, int G, int wave, int lane) {
    LAS float* scr = (LAS float*)(lds + wave * 9216);
    const int nfull = (SEQ / 256) * (2 * DFF / 256) % G;
    if (nfull > 0 && G - nfull >= 32) { if (bx >= nfull) convert_ffn_d<F8>(wd, Wd, scr, (bx - nfull) * NWAVES + wave, (G - nfull) * NWAVES, lane); }
    else convert_ffn_d<F8>(wd, Wd, scr, bx * NWAVES + wave, G * NWAVES, lane);
}
template <bool W8, bool M8> __device__ __forceinline__ void convert_mid(const float* w_in, const float* w_a, const float* w_b, const float* w_o, void* Win, f16_t* Win16, void* Wa, void* Wb, void* Wo, LAS float* scr, int gw, int ngw, int lane) {
    constexpr int NB_IN = 192 + 3 + 128;
    constexpr int I_IN = (DM / 64) * NB_IN, I_A = (SGW / 64) * (DM / 32), I_O = (DM / 64) * (DM / 32);
    for (int it = gw; it < I_IN + 2 * I_A + I_O; it += ngw) {
        if (it < I_IN) { const int kb = it / NB_IN, nb = it % NB_IN;
            if (!W8) {
                if (nb < 192) transpose_item(w_in, INW, DM, kb * 64, nb * 32, 32, (f16_t*)Win, nb * 32, scr, lane);
                else if (nb < 195) { const int j = nb - 192; transpose_item(w_in, INW, DM, kb * 64, 6144 + j * 32, j == 2 ? 16 : 32, (f16_t*)Win, 10240 + j * 32, scr, lane); }
                else { const int j = nb - 195; transpose_item(w_in, INW, DM, kb * 64, 6224 + j * 32, 32, (f16_t*)Win, 6144 + j * 32, scr, lane); } }
            else {
                if (nb < 160) transpose_item_f8(w_in, INW, DM, kb * 64, nb * 32, (f8_t*)Win, nb * 32, W_GU_MUL, scr, lane);
                else if (nb < 192) transpose_item(w_in, INW, DM, kb * 64, nb * 32, 32, Win16, (nb - 160) * 32, scr, lane);
                else if (nb < 195) { const int j = nb - 192; transpose_item(w_in, INW, DM, kb * 64, 6144 + j * 32, j == 2 ? 16 : 32, Win16, 1024 + j * 32, scr, lane); }
                else { const int j = nb - 195; transpose_item_f8(w_in, INW, DM, kb * 64, 6224 + j * 32, (f8_t*)Win, 5120 + j * 32, W_GU_MUL, scr, lane); } } }
        else if (it < I_IN + 2 * I_A) { const int r0 = it - I_IN, which = r0 >= I_A, r = r0 - which * I_A, kb = r / (DM / 32), nb = r % (DM / 32);
            if (M8) transpose_item_f8(which ? w_b : w_a, DM, SGW, kb * 64, nb * 32, (f8_t*)(which ? Wb : Wa), nb * 32, W_AB_MUL, scr, lane);
            else transpose_item(which ? w_b : w_a, DM, SGW, kb * 64, nb * 32, 32, (f16_t*)(which ? Wb : Wa), nb * 32, scr, lane); }
        else { const int r = it - I_IN - 2 * I_A, kb = r / (DM / 32), nb = r % (DM / 32);
            if (M8) transpose_item_f8(w_o, DM, DM, kb * 64, nb * 32, (f8_t*)Wo, nb * 32, W_GU_MUL, scr, lane);
            else transpose_item(w_o, DM, DM, kb * 64, nb * 32, 32, (f16_t*)Wo, nb * 32, scr, lane); }
    }
}

template <bool O8> __device__ __forceinline__ void norm_rows(const float* X, void* O, const LAS float* la, const LAS float* lsh, int gw, int ngw, int lane) {
    for (int m = gw; m < SEQ; m += ngw) {
        const f32x4* xr = (const f32x4*)(X + (size_t)m * DM) + lane;
        f32x4 v[8]; float s = 0.f;
#pragma unroll
        for (int j = 0; j < 8; ++j) { v[j] = xr[64 * j]; s += (v[j].x * v[j].x + v[j].y * v[j].y) + (v[j].z * v[j].z + v[j].w * v[j].w); }
        const float r = 1.0f / sqrtf(wave_sum(s) * (1.0f / DM) + EPS);
#pragma unroll
        for (int j = 0; j < 8; ++j) { const f32x4 a = *(const LAS f32x4*)(la + 4 * lane + 256 * j), sh = *(const LAS f32x4*)(lsh + 4 * lane + 256 * j);
            const float y0 = v[j].x * r * a.x + sh.x, y1 = v[j].y * r * a.y + sh.y, y2 = v[j].z * r * a.z + sh.z, y3 = v[j].w * r * a.w + sh.w;
            if (O8) ((unsigned*)((f8_t*)O + (size_t)m * DM))[lane + 64 * j] = pk_f8x4(y0, y1, y2, y3);
            else { u32x2 w; w.x = pk_h2(y0, y1); w.y = pk_h2(y2, y3); ((u32x2*)((f16_t*)O + (size_t)m * DM))[lane + 64 * j] = w; } }
    }
}
template <bool O8, bool ALSO8 = false> __device__ __forceinline__ void norm_rows_h(const f16_t* X, void* O, const LAS float* la, const LAS float* lsh, int gw, int ngw, int lane, f8_t* O2 = nullptr) {
    for (int m = gw; m < SEQ; m += ngw) {
        const h16x8* xr = (const h16x8*)(X + (size_t)m * DM) + lane;
        float v[4][8]; float s = 0.f;
#pragma unroll
        for (int j = 0; j < 4; ++j) { const h16x8 h8 = xr[64 * j];
#pragma unroll
            for (int e = 0; e < 8; ++e) { v[j][e] = (float)h8[e]; s += v[j][e] * v[j][e]; } }
        const float r = 1.0f / sqrtf(wave_sum(s) * (1.0f / DM) + EPS);
#pragma unroll
        for (int j = 0; j < 4; ++j) { const LAS float* a = la + 8 * lane + 512 * j; const LAS float* sh = lsh + 8 * lane + 512 * j;
            const f32x4 a0 = *(const LAS f32x4*)a, a1 = *(const LAS f32x4*)(a + 4), s0 = *(const LAS f32x4*)sh, s1 = *(const LAS f32x4*)(sh + 4);
            float y[8]; y[0] = v[j][0] * r * a0.x + s0.x; y[1] = v[j][1] * r * a0.y + s0.y; y[2] = v[j][2] * r * a0.z + s0.z; y[3] = v[j][3] * r * a0.w + s0.w;
            y[4] = v[j][4] * r * a1.x + s1.x; y[5] = v[j][5] * r * a1.y + s1.y; y[6] = v[j][6] * r * a1.z + s1.z; y[7] = v[j][7] * r * a1.w + s1.w;
            if (O8) { u32x2 w; w.x = pk_f8x4(y[0], y[1], y[2], y[3]); w.y = pk_f8x4(y[4], y[5], y[6], y[7]); ((u32x2*)((f8_t*)O + (size_t)m * DM))[lane + 64 * j] = w; }
            else { u32x4 w; w.x = pk_h2(y[0], y[1]); w.y = pk_h2(y[2], y[3]); w.z = pk_h2(y[4], y[5]); w.w = pk_h2(y[6], y[7]); ((u32x4*)((f16_t*)O + (size_t)m * DM))[lane + 64 * j] = w;
                if (ALSO8) { u32x2 w8; w8.x = pk_f8x4(y[0], y[1], y[2], y[3]); w8.y = pk_f8x4(y[4], y[5], y[6], y[7]); ((u32x2*)(O2 + (size_t)m * DM))[lane + 64 * j] = w8; } } }
    }
}
__device__ __forceinline__ void zero_h_pad(f8_t* H8, int gw, int ngw, int lane) { for (int r = gw; r < SEQ; r += ngw) if (lane < (DFF8 - DFF) / 16) *(u32x4*)(H8 + (size_t)r * DFF8 + DFF + 16 * lane) = (u32x4){0u, 0u, 0u, 0u}; }

constexpr int SGU_LD = 136, SGU_TILE_B = 128 * SGU_LD * 2;
__device__ __forceinline__ void sgu_load_ws(LAS unsigned char* lds, const float* w_sp, int g, int tid) {
    const int i = tid >> 2, j0 = (tid & 3) * 32; const float* src = w_sp + ((size_t)g * 128 + i) * 128 + j0;
    LAS unsigned char* dst = lds + (i * SGU_LD + j0) * 2;
#pragma unroll
    for (int q = 0; q < 4; ++q) { const f32x4 a = *(const f32x4*)(src + 8 * q), b = *(const f32x4*)(src + 8 * q + 4); float v[8] = {a.x, a.y, a.z, a.w, b.x, b.y, b.z, b.w};
#pragma unroll
        for (int e = 0; e < 8; ++e) if (j0 + 8 * q + e > i) v[e] = 0.f;
        u32x4 w; w.x = pk_h2(v[0], v[1]); w.y = pk_h2(v[2], v[3]); w.z = pk_h2(v[4], v[5]); w.w = pk_h2(v[6], v[7]);
        *(LAS u32x4*)(dst + 16 * q) = w; }
}
__device__ __forceinline__ void sgu_unit(LAS unsigned char* lds, f16_t* U, f8_t* A8, const f16_t* V, const float* g_sgu, const float* b_sp, int n, int g, int tid, int wave, int lane) {
    LAS unsigned char* ws_l = lds; LAS unsigned char* vt_l = lds + SGU_TILE_B;
    {
        const int j = tid >> 2, c0 = (tid & 3) * 32; const f16_t* src = V + (size_t)(n * 128 + j) * 1024 + g * 128 + c0;
        float v[32];
#pragma unroll
        for (int q = 0; q < 4; ++q) { const h16x8 a = *(const h16x8*)(src + 8 * q);
#pragma unroll
            for (int e = 0; e < 8; ++e) v[8 * q + e] = (float)a[e]; }
        float s = 0.f;
#pragma unroll
        for (int e = 0; e < 32; ++e) s += v[e] * v[e];
        s += __shfl_xor(s, 1); s += __shfl_xor(s, 2);
        const float r = 1.0f / sqrtf(s * (1.0f / 128) + EPS);
        const float* gp = g_sgu + g * 128 + c0;
#pragma unroll
        for (int e = 0; e < 32; ++e) { const _Float16 hv = (_Float16)(v[e] * r * gp[e]); *(LAS _Float16*)(vt_l + ((c0 + e) * SGU_LD + j) * 2) = hv; }
    }
    LDS_WAIT(); __syncthreads();
    const int li = lane & 15, kq = lane >> 4;
    f32x4 acc[8];
#pragma unroll
    for (int cb = 0; cb < 8; ++cb) acc[cb] = (f32x4){0.f, 0.f, 0.f, 0.f};
#pragma unroll
    for (int ks = 0; ks < 4; ++ks) {
        const h16x8 wf = *(const LAS h16x8*)(ws_l + ((16 * wave + li) * SGU_LD + 32 * ks + 8 * kq) * 2);
#pragma unroll
        for (int cb = 0; cb < 8; ++cb) { const h16x8 vf = *(const LAS h16x8*)(vt_l + ((16 * cb + li) * SGU_LD + 32 * ks + 8 * kq) * 2);
            acc[cb] = __builtin_amdgcn_mfma_f32_16x16x32_f16(vf, wf, acc[cb], 0, 0, 0); }
    }
    {
        const int i = 16 * wave + li; const float bias = b_sp[g * 128 + i];
        f16_t* up = U + (size_t)(n * 128 + i) * 1024 + g * 128 + 4 * kq;
#pragma unroll
        for (int cb = 0; cb < 8; ++cb) { const h16x4 uu = *(const h16x4*)(up + 16 * cb);
            const float r0 = (float)uu[0] * (acc[cb][0] + bias), r1 = (float)uu[1] * (acc[cb][1] + bias), r2 = (float)uu[2] * (acc[cb][2] + bias), r3 = (float)uu[3] * (acc[cb][3] + bias);
            if (A8) *(unsigned*)(A8 + (size_t)(n * 128 + i) * 1024 + g * 128 + 4 * kq + 16 * cb) = pk_f8x4(r0, r1, r2, r3);
            else { u32x2 o; o.x = pk_h2(r0, r1); o.y = pk_h2(r2, r3); *(u32x2*)(up + 16 * cb) = o; } }
    }
    __syncthreads();
}

#define FRESH_IDS const int lane = lane_id(); const int wave = wave0; const int tid = wave0 * 64 + lane; const int gw = bx * NWAVES + wave; (void)tid; (void)lane; (void)wave; (void)gw;
struct Args { const float* in[24]; float* out; unsigned char* ws; int ph_lo, ph_hi; };
constexpr int N_PHASES = 15;

__global__ void __launch_bounds__(NT, 2) fwd_kernel(Args args) {
    extern __shared__ __attribute__((aligned(16))) unsigned char lds_raw[];
    LAS unsigned char* lds = (LAS unsigned char*)lds_raw;
    volatile LAS unsigned* MISC = (volatile LAS unsigned*)(lds + LDS_MISC);
    const int wave0 = __builtin_amdgcn_readfirstlane((int)threadIdx.x >> 6);
    const int lane = lane_id(), wave = wave0, tid = wave0 * 64 + lane;
    const int G = gridDim.x, bx = blockIdx.x;
    const int gw = bx * NWAVES + wave, ngw = G * NWAVES;
    unsigned char* ws = args.ws;
    unsigned* ctl = (unsigned*)(ws + WS_CTL);
    if (tid < 64) MISC[tid] = 0u;
    __syncthreads();
    XcdBarrier bar = xcd_barrier_post(ctl + 4096, MISC + 8, tid == 0);
    const int lo = args.ph_lo, hi = args.ph_hi;
#define IN(k) (lo <= (k) && (k) < hi)
#define SEAM(k) do { if (IN(k) && IN((k) + 1)) xcd_barrier(bar, wave0 == 0 && lane_id() == 0); } while (0)

    const float* x = argp(0); float* out = args.out;
    float* adap = (float*)(ws + WS_ADAP); float* ada = (float*)(ws + WS_ADA);
    f16_t* Wt = (f16_t*)(ws + WS_WFF); f16_t* Wd = (f16_t*)(ws + WS_WFFD);
    f16_t* NB = (f16_t*)(ws + WS_NB); f16_t* HB = (f16_t*)(ws + WS_HB); f16_t* X1H = (f16_t*)(ws + WS_X1H);

    if (IN(0)) {
        FRESH_IDS
        ada_partial(argp(1), argp(2), adap, bx, tid);
        LAS float* scr = (LAS float*)(lds + wave * 9216);
        convert_ffn_gu<FFN1_F8>(argp(5), argp(6), Wt, scr, gw, ngw, lane);
        convert_mid<WIN_F8, MIX_F8>(argp(9), argp(17), argp(18), argp(19), ws + WS_WIN, (f16_t*)(ws + WS_WIN + 20 * MiB), ws + WS_WA, ws + WS_WB, ws + WS_WO, scr, gw, ngw, lane);
    }
    SEAM(0);
    if (IN(1)) {
        FRESH_IDS
        LAS float* la = (LAS float*)lds; LAS float* lsh = la + DM;
        const float* g1 = argp(4);
        for (int c = tid; c < DM; c += NT) { const float sh = ada_col(adap, argp(3), c), sc = ada_col(adap, argp(3), DM + c); la[c] = g1[c] * (1.0f + sc); lsh[c] = sh; }
        for (int c = bx * NT + tid; c < NADA; c += G * NT) ada[c] = ada_col(adap, argp(3), c);
        __syncthreads();
        norm_rows<FFN1_F8>(x, NB, la, lsh, gw, ngw, lane);
        if (FFN1_F8) zero_h_pad((f8_t*)HB, gw, ngw, lane);
        __syncthreads();
    }
    SEAM(1);
    if (IN(2)) {
        FRESH_IDS
        if constexpr (FFN1_F8) { pg8::Gemm g{NB, Wt, SEQ, 2 * DFF, DM / 2, E8M0_GU, E8M0_1}; pg8::StaticOrder S; S.init(SEQ, 2 * DFF, G, bx);
            pg8::EpiSwiGLU<true> E{HB, DFF8}; pg8::gemm_phase<pg8::EpiSwiGLU<true>, pg8::StaticOrder, true, true>(lds, g, S, E, wave0); }
        else { pg8::Gemm g{NB, Wt, SEQ, 2 * DFF, DM, 0u, 0u}; pg8::StaticOrder S; S.init(SEQ, 2 * DFF, G, bx);
            pg8::EpiSwiGLU<false> E{HB, DFF}; pg8::gemm_phase<pg8::EpiSwiGLU<false>, pg8::StaticOrder>(lds, g, S, E, wave0); }
        convert_down_in_tail<FFN1_F8>(argp(7), Wd, lds, bx, G, wave, lane);
    }
    SEAM(2);
    if (IN(3)) {
        FRESH_IDS
        pg8::StaticOrder S; S.init(SEQ, DM, G, bx);
        pg8::EpiResidH<false, true> E{x, X1H, ada + 2 * DM, 0.5f, DM};
        if constexpr (FFN1_F8) { pg8::Gemm g{HB, Wd, SEQ, DM, DFF8 / 2, E8M0_DH, E8M0_1}; pg8::gemm_phase<pg8::EpiResidH<false, true>, pg8::StaticOrder, true, true>(lds, g, S, E, wave0); }
        else { pg8::Gemm g{HB, Wd, SEQ, DM, DFF, 0u, 0u}; pg8::gemm_phase<pg8::EpiResidH<false, true>, pg8::StaticOrder>(lds, g, S, E, wave0); }
    }
    SEAM(3);
    f16_t* Z6 = (f16_t*)(ws + WS_Z6); f16_t* GAB = (f16_t*)(ws + WS_GAB);
    f16_t* KI = (f16_t*)(ws + WS_KI); float* WI = (float*)(ws + WS_WI);
    f16_t* ZU = Z6, *ZV = Z6 + (size_t)1 * SEQ * 1024, *ZQ = Z6 + (size_t)2 * SEQ * 1024, *ZK = Z6 + (size_t)3 * SEQ * 1024, *ZVV = Z6 + (size_t)4 * SEQ * 1024, *ZQI = Z6 + (size_t)5 * SEQ * 1024;
    f16_t* AO = ZQI;
    if (IN(4)) {
        FRESH_IDS
        LAS float* la = (LAS float*)lds; LAS float* lsh = la + DM;
        const float* g2 = argp(8);
        for (int c = tid; c < DM; c += NT) { la[c] = g2[c] * (1.0f + ada[4 * DM + c]); lsh[c] = ada[3 * DM + c]; }
        __syncthreads();
        norm_rows_h<false, WIN_F8>(X1H, NB, la, lsh, gw, ngw, lane, (f8_t*)(ws + WS_MASK));
        __syncthreads();
    }
    SEAM(4);
    if (IN(5)) {
        FRESH_IDS
        if constexpr (WIN_F8) {
            { pg8::Gemm g{(const f16_t*)(ws + WS_MASK), (const f16_t*)(ws + WS_WIN), SEQ, 36 * 256, DM / 2, E8M0_GU, E8M0_1}; pg8::StaticOrder S; S.init(SEQ, 36 * 256, G, bx);
              pg8::EpiWIN E{Z6, GAB, KI, WI, argp(15), argp(16), argp(13), argp(14), (LAS float*)(lds + 131072), 1};
              pg8::gemm_phase<pg8::EpiWIN, pg8::StaticOrder, true, true>(lds, g, S, E, wave0); }
            { pg8::Gemm g{NB, (const f16_t*)(ws + WS_WIN + 20 * MiB), SEQ, 5 * 256, DM, 0u, 0u}; pg8::StaticOrder S; S.init(SEQ, 5 * 256, G, bx);
              pg8::EpiWIN E{Z6, GAB, KI, WI, argp(15), argp(16), argp(13), argp(14), (LAS float*)(lds + 131072), 2};
              pg8::gemm_phase<pg8::EpiWIN, pg8::StaticOrder>(lds, g, S, E, wave0); }
        } else {
            pg8::Gemm g{NB, (const f16_t*)(ws + WS_WIN), SEQ, INW_PAD, DM, 0u, 0u}; pg8::StaticOrder S; S.init(SEQ, INW_PAD, G, bx);
            pg8::EpiWIN E{Z6, GAB, KI, WI, argp(15), argp(16), argp(13), argp(14), (LAS float*)(lds + 131072), 0};
            pg8::gemm_phase<pg8::EpiWIN, pg8::StaticOrder>(lds, g, S, E, wave0);
        }
    }
    SEAM(5);
    if (IN(7)) {
        const int nit = bx < 256 ? 2 * ((255 - bx) / G + 1) : 0;
#pragma unroll 1
        for (int it = 0; it < nit; ++it) { const int u0 = bx + (it >> 1) * G, u = (it & 1) ? 511 - u0 : u0;
            FRESH_IDS
            idx::unit(lds, ZQI, KI, WI, (unsigned long long*)(ws + WS_MASK), ws + WS_BINS, ctl + 8256, 32 * u, tid, wave, lane);
        }
    }
    SEAM(7);
    if (IN(8)) {
        FRESH_IDS
        int U; int tkt = att::att_phase(U, (char*)lds_raw, lds, ZQ, ZK, ZVV, AO, (const unsigned long long*)(ws + WS_MASK), ws + WS_BINS, ctl + 8256, ctl + 8192, ctl + 16384, bx, tid, wave0);
        LAS unsigned* tk = (LAS unsigned*)(lds + att::TAB_OFF + 24576 + 2048);
        int gl = -1;
        const int lane_ = lane_id(), tid_ = wave0 * 64 + lane_;
        __syncthreads();
        for (int si = tkt - U; si < (SEQ / 128) * 8; ) { const int g = si >> 7, n = si & 127;
            if (g != gl) { __syncthreads(); sgu_load_ws(lds, argp(11), g, tid_); gl = g; }
            sgu_unit(lds, ZU, MIX_F8 ? (f8_t*)(ws + WS_A8) : nullptr, ZV, argp(10), argp(12), n, g, tid_, wave0, lane_);
            if (tid_ == 0) tk[0] = __hip_atomic_fetch_add(ctl + 8192, 1u, __ATOMIC_RELAXED, __HIP_MEMORY_SCOPE_AGENT);
            __syncthreads();
            si = (int)tk[0] - U; }
    }
    SEAM(8);
    if (IN(9)) {
        FRESH_IDS
        att::att_combine(lds, ctl + 16384, ws + WS_BINS, AO, gw, ngw, lane, tid);
        pg8::StaticOrder S; S.init(SEQ, DM, G, bx);
        pg8::EpiBranch<false> E{GAB, NB, DM, nullptr};
        if constexpr (MIX_F8) { pg8::Gemm g{(const f16_t*)(ws + WS_A8), (const f16_t*)(ws + WS_WA), SEQ, DM, SGW / 2, E8M0_AB, E8M0_1}; pg8::gemm_phase<pg8::EpiBranch<false>, pg8::StaticOrder, true, true>(lds, g, S, E, wave0); }
        else { pg8::Gemm g{ZU, (const f16_t*)(ws + WS_WA), SEQ, DM, SGW, 0u, 0u}; pg8::gemm_phase<pg8::EpiBranch<false>, pg8::StaticOrder>(lds, g, S, E, wave0); }
    }
    SEAM(9);
    if (IN(10)) {
        FRESH_IDS
        pg8::StaticOrder S; S.init(SEQ, DM, G, bx);
        pg8::EpiBranch<true, MIX_F8> E{GATE_F8 ? (const f16_t*)((const f8_t*)GAB + (size_t)SEQ * DM) : GAB + (size_t)SEQ * DM, NB, DM, (f8_t*)ZV};
        if constexpr (MIX_F8) { pg8::Gemm g{AO, (const f16_t*)(ws + WS_WB), SEQ, DM, ATW / 2, E8M0_AB, E8M0_1}; pg8::gemm_phase<pg8::EpiBranch<true, MIX_F8>, pg8::StaticOrder, true, true>(lds, g, S, E, wave0); }
        else { pg8::Gemm g{AO, (const f16_t*)(ws + WS_WB), SEQ, DM, ATW, 0u, 0u}; pg8::gemm_phase<pg8::EpiBranch<true, MIX_F8>, pg8::StaticOrder>(lds, g, S, E, wave0); }
    }
    SEAM(10);
    if (IN(11)) {
        FRESH_IDS
        pg8::StaticOrder S; S.init(SEQ, DM, G, bx);
        pg8::EpiResidH<true, true> E{X1H, X1H, ada + 5 * DM, 1.0f, DM};
        if constexpr (MIX_F8) { pg8::Gemm g{ZV, (const f16_t*)(ws + WS_WO), SEQ, DM, DM / 2, E8M0_GU, E8M0_1}; pg8::gemm_phase<pg8::EpiResidH<true, true>, pg8::StaticOrder, true, true>(lds, g, S, E, wave0); }
        else { pg8::Gemm g{NB, (const f16_t*)(ws + WS_WO), SEQ, DM, DM, 0u, 0u}; pg8::gemm_phase<pg8::EpiResidH<true, true>, pg8::StaticOrder>(lds, g, S, E, wave0); }
    }
    SEAM(11);
    if (IN(12)) {
        FRESH_IDS
        LAS float* la = (LAS float*)lds; LAS float* lsh = la + DM;
        const float* g3 = argp(20);
        for (int c = tid; c < DM; c += NT) { la[c] = g3[c] * (1.0f + ada[7 * DM + c]); lsh[c] = ada[6 * DM + c]; }
        __syncthreads();
        norm_rows_h<FFN2_F8>(X1H, NB, la, lsh, gw, ngw, lane);
        if (FFN2_F8) zero_h_pad((f8_t*)HB, gw, ngw, lane);
        __syncthreads();
        LAS float* scr = (LAS float*)(lds + wave * 9216);
        convert_ffn_gu<FFN2_F8>(argp(21), argp(22), Wt, scr, gw, ngw, lane);
    }
    SEAM(12);
    if (IN(13)) {
        FRESH_IDS
        if constexpr (FFN2_F8) { pg8::Gemm g{NB, Wt, SEQ, 2 * DFF, DM / 2, E8M0_GU, E8M0_1}; pg8::StaticOrder S; S.init(SEQ, 2 * DFF, G, bx);
            pg8::EpiSwiGLU<true> E{HB, DFF8}; pg8::gemm_phase<pg8::EpiSwiGLU<true>, pg8::StaticOrder, true, true>(lds, g, S, E, wave0); }
        else { pg8::Gemm g{NB, Wt, SEQ, 2 * DFF, DM, 0u, 0u}; pg8::StaticOrder S; S.init(SEQ, 2 * DFF, G, bx);
            pg8::EpiSwiGLU<false> E{HB, DFF}; pg8::gemm_phase<pg8::EpiSwiGLU<false>, pg8::StaticOrder>(lds, g, S, E, wave0); }
        convert_down_in_tail<FFN2_F8>(argp(23), Wd, lds, bx, G, wave, lane);
    }
    SEAM(13);
    if (IN(14)) {
        FRESH_IDS
        pg8::StaticOrder S; S.init(SEQ, DM, G, bx);
        pg8::EpiResidH<true, false> E{X1H, out, ada + 8 * DM, 0.5f, DM};
        if constexpr (FFN2_F8) { pg8::Gemm g{HB, Wd, SEQ, DM, DFF8 / 2, E8M0_DH, E8M0_1}; pg8::gemm_phase<pg8::EpiResidH<true, false>, pg8::StaticOrder, true, true>(lds, g, S, E, wave0); }
        else { pg8::Gemm g{HB, Wd, SEQ, DM, DFF, 0u, 0u}; pg8::gemm_phase<pg8::EpiResidH<true, false>, pg8::StaticOrder>(lds, g, S, E, wave0); }
    }
#undef IN
#undef SEAM
}

extern "C" void kernel_launch(void* const* d_in, const int* in_sizes, int n_in, void* d_out, int out_size, void* d_ws, size_t ws_size, hipStream_t stream) {
    static int grid = 0;
    if (grid == 0) {
        if (n_in != 24 || in_sizes[0] != SEQ * DM || out_size != SEQ * DM || ws_size < WS_END) { fprintf(stderr, "kernel_launch: unexpected shapes (n_in %d, in0 %d, out %d, ws %zu)\n", n_in, n_in > 0 ? in_sizes[0] : -1, out_size, ws_size); grid = -1; return; }
        int dev = 0, cus = 0;
        if (hipGetDevice(&dev) != hipSuccess || hipDeviceGetAttribute(&cus, hipDeviceAttributeMultiprocessorCount, dev) != hipSuccess) { grid = -1; return; }
        if (hipFuncSetAttribute((const void*)fwd_kernel, hipFuncAttributeMaxDynamicSharedMemorySize, LDS_BYTES) != hipSuccess) { fprintf(stderr, "kernel_launch: hipFuncSetAttribute failed\n"); grid = -1; return; }
        int per_cu = 0;
        if (hipOccupancyMaxActiveBlocksPerMultiprocessor(&per_cu, (const void*)fwd_kernel, NT, LDS_BYTES) != hipSuccess || per_cu < 1) fprintf(stderr, "kernel_launch: occupancy query says %d\n", per_cu);
        (void)hipGetLastError();
        grid = cus;
    }
    if (grid < 0) return;
    (void)hipMemsetAsync((char*)d_ws + WS_CTL, 0, CTL_ZERO_BYTES, stream);
    Args a{};
    for (int i = 0; i < 24; ++i) a.in[i] = (const float*)d_in[i];
    a.out = (float*)d_out; a.ws = (unsigned char*)d_ws;
    a.ph_lo = 0; a.ph_hi = N_PHASES;
    hipLaunchKernelGGL(fwd_kernel, dim3(grid), dim3(NT), LDS_BYTES, stream, a);
}
```

```cpp
#include <hip/hip_runtime.h>
#include <cstdio>
#include <cstdint>

#define LAS __attribute__((address_space(3)))
#define GAS __attribute__((address_space(1)))
typedef unsigned short f16_t;
typedef _Float16 h16x8 __attribute__((ext_vector_type(8)));
typedef _Float16 h16x2 __attribute__((ext_vector_type(2)));
typedef _Float16 h16x4 __attribute__((ext_vector_type(4)));
typedef short s16x8 __attribute__((ext_vector_type(8)));
typedef short s16x4 __attribute__((ext_vector_type(4)));
typedef float f32x2 __attribute__((ext_vector_type(2)));
typedef float f32x4 __attribute__((ext_vector_type(4)));
typedef float f32x16 __attribute__((ext_vector_type(16)));
typedef unsigned u32x2 __attribute__((ext_vector_type(2)));
typedef unsigned u32x4 __attribute__((ext_vector_type(4)));
typedef int i32x4 __attribute__((ext_vector_type(4)));
typedef int i32x8 __attribute__((ext_vector_type(8)));
typedef unsigned char f8_t;

constexpr int SEQ = 16384, DM = 2048, DFF = 5504, NADA = 9 * DM;
constexpr int SGW = 1024, ATW = 1024, NHEAD = 8, HD = 128, IH = 16, IDIM = 64, TOPK = 256;
constexpr int INW = 10320, INW_PAD = 10496;
constexpr float EPS = 1e-6f;
constexpr bool FFN1_F8 = true, FFN2_F8 = true;
constexpr bool EARLY_W2 = true;
constexpr bool GATE_F8 = true;
constexpr float GATE_MUL = 256.f, M1_MUL = 16.f;
constexpr bool MIX_F8 = true;
constexpr bool WIN_F8 = true;
constexpr int DFF8 = 5632;
constexpr float W_GU_MUL = 32.f, W_D_MUL = 64.f, H_MUL = 4.f;
constexpr float W_AB_MUL = 16.f; constexpr unsigned E8M0_AB = 0x7b7b7b7bu  ;
constexpr unsigned E8M0_1 = 0x7f7f7f7fu, E8M0_GU = 0x7a7a7a7au  , E8M0_DH = 0x77777777u  ;
constexpr int NWAVES = 8, NT = 512;
#define LDS_WAIT() asm volatile("s_waitcnt lgkmcnt(0)" ::: "memory")

__device__ __forceinline__ int lane_id() { int l = (int)__builtin_amdgcn_mbcnt_hi(~0u, __builtin_amdgcn_mbcnt_lo(~0u, 0u)); asm volatile("" : "+v"(l)); return l; }
template <int M> __device__ __forceinline__ float swz_xor(float v) { return __builtin_bit_cast(float, __builtin_amdgcn_ds_swizzle(__builtin_bit_cast(int, v), (M << 10) | 0x1f)); }
__device__ __forceinline__ unsigned pk_h2(float lo, float hi) { f32x2 v = {lo, hi}; return __builtin_bit_cast(unsigned, __builtin_convertvector(v, h16x2)); }
__device__ __forceinline__ unsigned pk_f8x4(float a, float b, float c, float d) { int w = 0; w = __builtin_amdgcn_cvt_pk_fp8_f32(a, b, w, false); w = __builtin_amdgcn_cvt_pk_fp8_f32(c, d, w, true); return (unsigned)w; }
__device__ __forceinline__ float h2f(f16_t h) { return (float)__builtin_bit_cast(_Float16, h); }
__device__ __forceinline__ float fexp2(float x) { return __builtin_amdgcn_exp2f(x); }
__device__ __forceinline__ float frcp(float x) { return __builtin_amdgcn_rcpf(x); }
__device__ __forceinline__ float silu_f(float x) { return x * frcp(1.0f + fexp2(-1.4426950409f * x)); }
__device__ __forceinline__ float sigmoid_f(float x) { return frcp(1.0f + fexp2(-1.4426950409f * x)); }
__device__ __forceinline__ float gelu_f(float x) {
    const float t = x * x; const float e = fexp2(x * (-2.3022081981f - 0.1029432398f * t));
    return x * frcp(1.0f + e);
}

namespace pg8 {
constexpr int BM = 256, BK = 64, HALF = 128, HTB = HALF * BK * 2, STAGE_BYTES = 8 * HTB, NXCD = 8, WGM = 8;
__host__ __device__ __forceinline__ int lds_byte(int r, int c) { const int st = (r >> 4) * 2 + (c >> 5), rr = r & 15, cc = c & 31, ob = rr * 64 + cc * 2; return st * 1024 + (ob ^ (((ob >> 9) & 1) << 5)); }
__host__ __device__ __forceinline__ void stage_rc(int b, int& R, int& C) { const int st = b / 1024, sb = b % 1024, swz = sb ^ (((sb >> 9) & 1) << 5); R = (st >> 1) * 16 + swz / 64; C = (st & 1) * 32 + (swz % 64) / 2; }
__host__ __device__ __forceinline__ int perm32(int rho) { const int n = rho >> 4, i = rho & 15; return 8 * (i >> 2) + 4 * n + (i & 3); }

struct Unit { int pm, pn; };
struct Gemm { const f16_t* A; const f16_t* Bt; int M, N, K; unsigned sca, scb; };

struct StaticOrder {
    int nM, nN, nwg, G, c;
    __host__ __device__ void init(int M, int N, int G_, int c_) { nM = M / BM; nN = N / BM; nwg = nM * nN; G = G_; c = c_; }
    __host__ __device__ bool next(int i, Unit& u) const {
        const long L = (long)i * G + c; if (L >= nwg) return false;
        int wgid = (int)L; { const int q = nwg / NXCD, r = nwg % NXCD, xcd = wgid % NXCD, off = wgid / NXCD; wgid = (xcd < r ? xcd * (q + 1) : r * (q + 1) + (xcd - r) * q) + off; }
        const int nig = WGM * nN, gid = wgid / nig, fm = gid * WGM, gsz = (nM - fm) < WGM ? (nM - fm) : WGM;
        u.pm = fm + ((wgid % nig) % gsz); u.pn = (wgid % nig) / gsz; return true;
    }
    __device__ __forceinline__ void a_ready(const Unit&) const {}
    __device__ __forceinline__ void done(const Unit&) const {}
};
struct BalOrder : StaticOrder {
    __device__ __forceinline__ bool next(int i, Unit& u) const {
        if (G != 256 || nwg != 9 * 256) return StaticOrder::next(i, u);
        if (c < 64) return i < 8 ? StaticOrder::next(i, u) : false;
        if (i < 9) return StaticOrder::next(i, u);
        if (i == 9 && c < 128) { StaticOrder t = *this; t.c = c - 64; return t.next(8, u); }
        return false;
    }
};

template <bool OUT8> struct EpiSwiGLU {
    static constexpr bool PERM = true, AFTER_DRAIN = false;
    void* H; int ldc;
    __device__ __forceinline__ void operator()(const f32x4 (&acc)[2][2][4][2], const Unit& u, int wr, int wc, int fr, int fq) const {
        const int row0 = u.pm * BM + wr * 64 + fr, col0 = u.pn * HALF + wc * 32 + 8 * fq;
#pragma unroll
        for (int ai = 0; ai < 2; ++ai)
#pragma unroll
            for (int m = 0; m < 4; ++m) {
                const f32x4 g0 = acc[ai][0][m][0], g1 = acc[ai][0][m][1], u0 = acc[ai][1][m][0], u1 = acc[ai][1][m][1];
                float h[8];
#pragma unroll
                for (int j = 0; j < 4; ++j) { h[j] = silu_f(g0[j]) * u0[j]; h[4 + j] = silu_f(g1[j]) * u1[j]; }
                if (OUT8) { u32x2 w; w.x = pk_f8x4(h[0] * H_MUL, h[1] * H_MUL, h[2] * H_MUL, h[3] * H_MUL); w.y = pk_f8x4(h[4] * H_MUL, h[5] * H_MUL, h[6] * H_MUL, h[7] * H_MUL);
                    *(u32x2*)((f8_t*)H + (size_t)(row0 + ai * HALF + m * 16) * ldc + col0) = w; }
                else { u32x4 w; w.x = pk_h2(h[0], h[1]); w.y = pk_h2(h[2], h[3]); w.z = pk_h2(h[4], h[5]); w.w = pk_h2(h[6], h[7]);
                    *(u32x4*)((f16_t*)H + (size_t)(row0 + ai * HALF + m * 16) * ldc + col0) = w; }
            }
    }
};
template <bool BIN_H, bool OUT_H> struct EpiResidH {
    static constexpr bool PERM = true, AFTER_DRAIN = false;
    const void* base; void* out; const float* gate; float gscale; int ldc;
    __device__ __forceinline__ void operator()(const f32x4 (&acc)[2][2][4][2], const Unit& u, int wr, int wc, int fr, int fq) const {
        const int row0 = u.pm * BM + wr * 64 + fr, col0 = u.pn * BM + wc * 32 + 8 * fq;
        f32x4 gv[2][2];
#pragma unroll
        for (int bj = 0; bj < 2; ++bj)
#pragma unroll
            for (int n = 0; n < 2; ++n) gv[bj][n] = *(const f32x4*)(gate + col0 + bj * HALF + n * 4) * gscale;
#pragma unroll
        for (int ai = 0; ai < 2; ++ai)
#pragma unroll
            for (int m = 0; m < 4; ++m) { const size_t off = (size_t)(row0 + ai * HALF + m * 16) * ldc + col0;
#pragma unroll
                for (int bj = 0; bj < 2; ++bj) { f32x4 b0, b1;
                    if (BIN_H) { const h16x8 hb = *(const h16x8*)((const f16_t*)base + off + bj * HALF); b0 = (f32x4){(float)hb[0], (float)hb[1], (float)hb[2], (float)hb[3]}; b1 = (f32x4){(float)hb[4], (float)hb[5], (float)hb[6], (float)hb[7]}; }
                    else { b0 = __builtin_nontemporal_load((const f32x4*)((const float*)base + off + bj * HALF)); b1 = __builtin_nontemporal_load((const f32x4*)((const float*)base + off + bj * HALF + 4)); }
                    const f32x4 r0 = b0 + gv[bj][0] * acc[ai][bj][m][0], r1 = b1 + gv[bj][1] * acc[ai][bj][m][1];
                    if (OUT_H) { u32x4 w; w.x = pk_h2(r0[0], r0[1]); w.y = pk_h2(r0[2], r0[3]); w.z = pk_h2(r1[0], r1[1]); w.w = pk_h2(r1[2], r1[3]); *(u32x4*)((f16_t*)out + off + bj * HALF) = w; }
                    else { __builtin_nontemporal_store(r0, (f32x4*)((float*)out + off + bj * HALF)); __builtin_nontemporal_store(r1, (f32x4*)((float*)out + off + bj * HALF + 4)); } } }
    }
};
template <int ACT> __device__ __forceinline__ float act_f(float x) { if (ACT == 1) return gelu_f(x); if (ACT == 2) return sigmoid_f(x); return x; }
template <int ACT> __device__ __forceinline__ void store_tile_f8(const f32x4 (&acc)[2][2][4][2], f8_t* dst, int ldc, int row0, int col0, float mul) {
#pragma unroll
    for (int ai = 0; ai < 2; ++ai)
#pragma unroll
        for (int m = 0; m < 4; ++m) { f8_t* rowp = dst + (size_t)(row0 + ai * HALF + m * 16) * ldc + col0;
#pragma unroll
            for (int bj = 0; bj < 2; ++bj) { const f32x4 v0 = acc[ai][bj][m][0], v1 = acc[ai][bj][m][1]; u32x2 w;
                w.x = pk_f8x4(act_f<ACT>(v0[0]) * mul, act_f<ACT>(v0[1]) * mul, act_f<ACT>(v0[2]) * mul, act_f<ACT>(v0[3]) * mul);
                w.y = pk_f8x4(act_f<ACT>(v1[0]) * mul, act_f<ACT>(v1[1]) * mul, act_f<ACT>(v1[2]) * mul, act_f<ACT>(v1[3]) * mul);
                *(u32x2*)(rowp + bj * HALF) = w; } }
}
template <int ACT> __device__ __forceinline__ void store_tile_h(const f32x4 (&acc)[2][2][4][2], f16_t* dst, int ldc, int row0, int col0) {
#pragma unroll
    for (int ai = 0; ai < 2; ++ai)
#pragma unroll
        for (int m = 0; m < 4; ++m) { f16_t* rowp = dst + (size_t)(row0 + ai * HALF + m * 16) * ldc + col0;
#pragma unroll
            for (int bj = 0; bj < 2; ++bj) { const f32x4 v0 = acc[ai][bj][m][0], v1 = acc[ai][bj][m][1]; u32x4 w;
                w.x = pk_h2(act_f<ACT>(v0[0]), act_f<ACT>(v0[1])); w.y = pk_h2(act_f<ACT>(v0[2]), act_f<ACT>(v0[3]));
                w.z = pk_h2(act_f<ACT>(v1[0]), act_f<ACT>(v1[1])); w.w = pk_h2(act_f<ACT>(v1[2]), act_f<ACT>(v1[3]));
                *(u32x4*)(rowp + bj * HALF) = w; } }
}
struct EpiWIN {
    static constexpr bool PERM = true, AFTER_DRAIN = false;
    f16_t* Z6;
    f16_t* GAB;
    f16_t* KI; float* WI;
    const float* gki; const float* bki;
    const float* gq; const float* gk;
    LAS float* xch;
    int mode;
    __device__ __forceinline__ void operator()(const f32x4 (&acc)[2][2][4][2], const Unit& u, int wr, int wc, int fr, int fq) const {
        const int row0 = u.pm * BM + wr * 64 + fr, cin = wc * 32 + 8 * fq;
        const int pn = mode == 0 ? u.pn : (mode == 1 ? (u.pn < 20 ? u.pn : u.pn + 4) : (u.pn < 4 ? 20 + u.pn : 40));
        if (pn < 8) { store_tile_h<1>(acc, Z6 + (size_t)(pn >> 2) * SEQ * 1024, 1024, row0, (pn & 3) * 256 + cin); }
        else if (pn < 16) {
            const float* g = pn < 12 ? gq : gk;
            float ss[2][4][2];
#pragma unroll
            for (int ai = 0; ai < 2; ++ai)
#pragma unroll
                for (int m = 0; m < 4; ++m)
#pragma unroll
                    for (int bj = 0; bj < 2; ++bj) { const f32x4 a = acc[ai][bj][m][0], b = acc[ai][bj][m][1];
                        float t = (a[0] * a[0] + a[1] * a[1]) + (a[2] * a[2] + a[3] * a[3]) + (b[0] * b[0] + b[1] * b[1]) + (b[2] * b[2] + b[3] * b[3]);
                        t += __shfl_xor(t, 16); t += __shfl_xor(t, 32); ss[ai][m][bj] = t; }
            if (fq == 0) {
#pragma unroll
                for (int ai = 0; ai < 2; ++ai)
#pragma unroll
                    for (int m = 0; m < 4; ++m)
#pragma unroll
                        for (int bj = 0; bj < 2; ++bj) xch[((ai * HALF + wr * 64 + m * 16 + fr) * 2 + bj) * 4 + wc] = ss[ai][m][bj]; }
            asm volatile("s_waitcnt lgkmcnt(0)" ::: "memory"); __builtin_amdgcn_s_barrier(); asm volatile("" ::: "memory");
            f32x4 gv[2]; gv[0] = *(const f32x4*)(g + cin); gv[1] = *(const f32x4*)(g + cin + 4);
            f16_t* dst = Z6 + (size_t)(pn >> 2) * SEQ * 1024; const int col0 = (pn & 3) * 256 + cin;
#pragma unroll
            for (int ai = 0; ai < 2; ++ai)
#pragma unroll
                for (int m = 0; m < 4; ++m) { f16_t* rowp = dst + (size_t)(row0 + ai * HALF + m * 16) * 1024 + col0;
#pragma unroll
                    for (int bj = 0; bj < 2; ++bj) { const f32x4 pr = *(const LAS f32x4*)(xch + ((ai * HALF + wr * 64 + m * 16 + fr) * 2 + bj) * 4);
                        const float r = 1.0f / sqrtf(((pr[0] + pr[1]) + (pr[2] + pr[3])) * (1.0f / 128) + EPS);
                        const f32x4 v0 = acc[ai][bj][m][0] * gv[0] * r, v1 = acc[ai][bj][m][1] * gv[1] * r; u32x4 w;
                        w.x = pk_h2(v0[0], v0[1]); w.y = pk_h2(v0[2], v0[3]); w.z = pk_h2(v1[0], v1[1]); w.w = pk_h2(v1[2], v1[3]);
                        *(u32x4*)(rowp + bj * HALF) = w; } }
        }
        else if (pn < 24) { store_tile_h<0>(acc, Z6 + (size_t)(pn >> 2) * SEQ * 1024, 1024, row0, (pn & 3) * 256 + cin); }
        else if (pn < 40) { if (GATE_F8) store_tile_f8<2>(acc, (f8_t*)GAB + (size_t)((pn - 24) >> 3) * SEQ * 2048, 2048, row0, ((pn - 24) & 7) * 256 + cin, GATE_MUL);
                            else store_tile_h<2>(acc, GAB + (size_t)((pn - 24) >> 3) * SEQ * 2048, 2048, row0, ((pn - 24) & 7) * 256 + cin); }
        else {
            float s1[2][4], s2[2][4];
#pragma unroll
            for (int ai = 0; ai < 2; ++ai)
#pragma unroll
                for (int m = 0; m < 4; ++m) { const f32x4 a = acc[ai][0][m][0], b = acc[ai][0][m][1];
                    float t1 = (a[0] + a[1]) + (a[2] + a[3]) + (b[0] + b[1]) + (b[2] + b[3]);
                    float t2 = (a[0] * a[0] + a[1] * a[1]) + (a[2] * a[2] + a[3] * a[3]) + (b[0] * b[0] + b[1] * b[1]) + (b[2] * b[2] + b[3] * b[3]);
                    t1 += __shfl_xor(t1, 16); t1 += __shfl_xor(t1, 32); t2 += __shfl_xor(t2, 16); t2 += __shfl_xor(t2, 32); s1[ai][m] = t1; s2[ai][m] = t2; }
            if (fq == 0 && wc < 2) {
#pragma unroll
                for (int ai = 0; ai < 2; ++ai)
#pragma unroll
                    for (int m = 0; m < 4; ++m) { const int rl = ai * HALF + wr * 64 + m * 16 + fr; xch[(rl * 4 + wc) * 2] = s1[ai][m]; xch[(rl * 4 + wc) * 2 + 1] = s2[ai][m]; } }
            asm volatile("s_waitcnt lgkmcnt(0)" ::: "memory"); __builtin_amdgcn_s_barrier(); asm volatile("" ::: "memory");
            if (wc < 2) {
                const f32x4 g0 = *(const f32x4*)(gki + cin), g1 = *(const f32x4*)(gki + cin + 4), b0 = *(const f32x4*)(bki + cin), b1 = *(const f32x4*)(bki + cin + 4);
#pragma unroll
                for (int ai = 0; ai < 2; ++ai)
#pragma unroll
                    for (int m = 0; m < 4; ++m) { const int rl = ai * HALF + wr * 64 + m * 16 + fr; const f32x4 pr = *(const LAS f32x4*)(xch + rl * 8);
                        const float mu = (pr[0] + pr[2]) * (1.0f / IDIM), var = fmaxf((pr[1] + pr[3]) * (1.0f / IDIM) - mu * mu, 0.f), r = 1.0f / sqrtf(var + EPS);
                        const f32x4 v0 = (acc[ai][0][m][0] - mu) * r * g0 + b0, v1 = (acc[ai][0][m][1] - mu) * r * g1 + b1; u32x4 w;
                        w.x = pk_h2(v0[0], v0[1]); w.y = pk_h2(v0[2], v0[3]); w.z = pk_h2(v1[0], v1[1]); w.w = pk_h2(v1[2], v1[3]);
                        *(u32x4*)(KI + (size_t)(row0 + ai * HALF + m * 16) * IDIM + cin) = w; } }
            else if (wc == 2 && fq < 2) {
#pragma unroll
                for (int ai = 0; ai < 2; ++ai)
#pragma unroll
                    for (int m = 0; m < 4; ++m) { float* wp = WI + (size_t)(row0 + ai * HALF + m * 16) * IH + (cin - 64);
                        *(f32x4*)wp = acc[ai][0][m][0] * 0.03125f; *(f32x4*)(wp + 4) = acc[ai][0][m][1] * 0.03125f; } }
        }
    }
};
template <bool ADD, bool OUT8 = false> struct EpiBranch {
    static constexpr bool PERM = true, AFTER_DRAIN = false;
    const f16_t* G; f16_t* M1; int ldc; f8_t* O8;
    __device__ __forceinline__ void operator()(const f32x4 (&acc)[2][2][4][2], const Unit& u, int wr, int wc, int fr, int fq) const {
        const int row0 = u.pm * BM + wr * 64 + fr, col0 = u.pn * BM + wc * 32 + 8 * fq;
#pragma unroll
        for (int ai = 0; ai < 2; ++ai)
#pragma unroll
            for (int m = 0; m < 4; ++m) { const size_t off = (size_t)(row0 + ai * HALF + m * 16) * ldc + col0;
#pragma unroll
                for (int bj = 0; bj < 2; ++bj) {
                    const f32x4 v0 = acc[ai][bj][m][0], v1 = acc[ai][bj][m][1];
                    float r[8];
                    if (GATE_F8) { const u32x2 g = *(const u32x2*)((const f8_t*)G + off + bj * HALF);
                        const f32x2 g0 = __builtin_amdgcn_cvt_pk_f32_fp8((int)g.x, false), g1 = __builtin_amdgcn_cvt_pk_f32_fp8((int)g.x, true), g2 = __builtin_amdgcn_cvt_pk_f32_fp8((int)g.y, false), g3 = __builtin_amdgcn_cvt_pk_f32_fp8((int)g.y, true);
                        constexpr float GI = 1.0f / GATE_MUL;
                        r[0] = g0[0] * GI * v0[0]; r[1] = g0[1] * GI * v0[1]; r[2] = g1[0] * GI * v0[2]; r[3] = g1[1] * GI * v0[3];
                        r[4] = g2[0] * GI * v1[0]; r[5] = g2[1] * GI * v1[1]; r[6] = g3[0] * GI * v1[2]; r[7] = g3[1] * GI * v1[3];
                        if (ADD) { const u32x2 q = *(const u32x2*)((const f8_t*)M1 + off + bj * HALF);
                            const f32x2 q0 = __builtin_amdgcn_cvt_pk_f32_fp8((int)q.x, false), q1 = __builtin_amdgcn_cvt_pk_f32_fp8((int)q.x, true), q2 = __builtin_amdgcn_cvt_pk_f32_fp8((int)q.y, false), q3 = __builtin_amdgcn_cvt_pk_f32_fp8((int)q.y, true);
                            constexpr float MI = 1.0f / M1_MUL;
                            r[0] += q0[0] * MI; r[1] += q0[1] * MI; r[2] += q1[0] * MI; r[3] += q1[1] * MI; r[4] += q2[0] * MI; r[5] += q2[1] * MI; r[6] += q3[0] * MI; r[7] += q3[1] * MI; }
                    } else { const h16x8 g = *(const h16x8*)(G + off + bj * HALF);
#pragma unroll
                        for (int j = 0; j < 4; ++j) { r[j] = (float)g[j] * v0[j]; r[4 + j] = (float)g[4 + j] * v1[j]; }
                        if (ADD) { const h16x8 p = *(const h16x8*)(M1 + off + bj * HALF);
#pragma unroll
                            for (int j = 0; j < 8; ++j) r[j] += (float)p[j]; } }
                    if (OUT8) { u32x2 w; w.x = pk_f8x4(r[0], r[1], r[2], r[3]); w.y = pk_f8x4(r[4], r[5], r[6], r[7]); *(u32x2*)(O8 + off + bj * HALF) = w; }
                    else if (GATE_F8) { u32x2 w; w.x = pk_f8x4(r[0] * M1_MUL, r[1] * M1_MUL, r[2] * M1_MUL, r[3] * M1_MUL); w.y = pk_f8x4(r[4] * M1_MUL, r[5] * M1_MUL, r[6] * M1_MUL, r[7] * M1_MUL); *(u32x2*)((f8_t*)M1 + off + bj * HALF) = w; }
                    else { u32x4 w; w.x = pk_h2(r[0], r[1]); w.y = pk_h2(r[2], r[3]); w.z = pk_h2(r[4], r[5]); w.w = pk_h2(r[6], r[7]);
                        *(u32x4*)(M1 + off + bj * HALF) = w; } } }
    }
};

__device__ __forceinline__ i32x8 cat8(h16x8 a, h16x8 b) { const i32x4 x = __builtin_bit_cast(i32x4, a), y = __builtin_bit_cast(i32x4, b); return __builtin_shufflevector(x, y, 0, 1, 2, 3, 4, 5, 6, 7); }
template <class Epi, class Sched, bool ALIGN_EPI = true, bool F8 = false>
__device__ __forceinline__ void gemm_phase(LAS unsigned char* lds, const Gemm g, const Sched& S, const Epi& E, int wid) {
    const int lane = lane_id(), tid = wid * 64 + lane, wr = wid >> 2, wc = wid & 3, fr = lane & 15, fq = lane >> 4;
    const int K = g.K, nt = K / BK;
    unsigned voffA[2], voffB[2];
#pragma unroll
    for (int i = 0; i < 2; ++i) { int R, C; stage_rc(tid * 16 + i * 8192, R, C); const int Rb = Epi::PERM ? ((R & ~31) + perm32(R & 31)) : R;
        voffA[i] = (unsigned)(R * K + C) * 2u; voffB[i] = (unsigned)(Rb * K + C) * 2u; }
    const size_t kstep = (size_t)(BK * 2);
    const size_t hstep = (size_t)HALF * K * 2;
    const size_t tstep = 2 * hstep;
    const unsigned ldsw = (unsigned)wid * 1024u;
    const int aoff = lds_byte(wr * 64 + fr, fq * 8), boff = lds_byte(wc * 32 + fr, fq * 8);
#define PG8_SA(b, h) (((b) * 2 + (h)) * HTB)
#define PG8_SB(b, h) ((4 + (b) * 2 + (h)) * HTB)
#define PG8_STAGE(bufoff, gbase, voff) do { _Pragma("unroll") for (int _i = 0; _i < 2; ++_i) \
        __builtin_amdgcn_global_load_lds((const unsigned*)((const char*)(gbase) + (voff)[_i]), (LAS unsigned*)(lds + (bufoff) + ldsw + _i * 8192), 16, 0, 0); } while (0)
#define PG8_LDA(dst, b, h) do { _Pragma("unroll") for (int m = 0; m < 4; ++m) { const i32x4 lo_ = *(const LAS i32x4*)(pa_ + (PG8_SA(b, h) + m * 2048)), hi_ = *(const LAS i32x4*)(pa_ + (PG8_SA(b, h) + m * 2048 + 1024)); \
        dst[m] = __builtin_shufflevector(lo_, hi_, 0, 1, 2, 3, 4, 5, 6, 7); } } while (0)
#define PG8_LDB(dst, b, h) do { _Pragma("unroll") for (int n = 0; n < 2; ++n) { const i32x4 lo_ = *(const LAS i32x4*)(pb_ + (PG8_SB(b, h) - 65536 + n * 2048)), hi_ = *(const LAS i32x4*)(pb_ + (PG8_SB(b, h) - 65536 + n * 2048 + 1024)); \
        dst[n] = __builtin_shufflevector(lo_, hi_, 0, 1, 2, 3, 4, 5, 6, 7); } } while (0)
#define PG8_H(v, k) __builtin_bit_cast(h16x8, __builtin_shufflevector(v, v, 4 * (k), 4 * (k) + 1, 4 * (k) + 2, 4 * (k) + 3))
#define PG8_MMA(ai, bj, At, Bt) do { __builtin_amdgcn_s_setprio(1); _Pragma("unroll") for (int m = 0; m < 4; ++m) _Pragma("unroll") for (int n = 0; n < 2; ++n) { \
        if constexpr (F8) asm volatile("v_mfma_scale_f32_16x16x128_f8f6f4 %0, %1, %2, %0, %3, %4 op_sel_hi:[0,0,0]" : "+v"(acc[ai][bj][m][n]) : "v"(Bt[n]), "v"(At[m]), "v"(vsca), "v"(vscb)); \
        else { acc[ai][bj][m][n] = __builtin_amdgcn_mfma_f32_16x16x32_f16(PG8_H(Bt[n], 0), PG8_H(At[m], 0), acc[ai][bj][m][n], 0, 0, 0); \
               acc[ai][bj][m][n] = __builtin_amdgcn_mfma_f32_16x16x32_f16(PG8_H(Bt[n], 1), PG8_H(At[m], 1), acc[ai][bj][m][n], 0, 0, 0); } } \
        __builtin_amdgcn_s_setprio(0); } while (0)
#define PG8_WAIT_V(n) asm volatile("s_waitcnt vmcnt(" #n ")" ::: "memory")
#define PG8_WAIT_L(n) asm volatile("s_waitcnt lgkmcnt(" #n ")" ::: "memory")
#define PG8_BAR __builtin_amdgcn_s_barrier()
#define PG8_SCHED __builtin_amdgcn_sched_barrier(0)
    Unit cur, nxt; int ui = 0;
    if (!S.next(0, cur)) return;
    f32x4 acc[2][2][4][2];
#pragma unroll
    for (int a = 0; a < 2; ++a)
#pragma unroll
        for (int b = 0; b < 2; ++b)
#pragma unroll
            for (int m = 0; m < 4; ++m)
#pragma unroll
                for (int n = 0; n < 2; ++n) acc[a][b][m][n] = (f32x4){0.f, 0.f, 0.f, 0.f};
    const LAS unsigned char* pa_ = lds + aoff; const LAS unsigned char* pb_ = lds + 65536 + boff;
    const int vsca = (int)g.sca, vscb = (int)g.scb; (void)vsca; (void)vscb;
    i32x8 At[4], B0[2], B1[2];
    const char* cA = (const char*)g.A + (size_t)cur.pm * tstep; const char* cB = (const char*)g.Bt + (size_t)cur.pn * tstep;
    S.a_ready(cur);
    PG8_STAGE(PG8_SB(0, 0), cB, voffB); PG8_STAGE(PG8_SB(0, 1), cB + hstep, voffB); PG8_STAGE(PG8_SA(0, 0), cA, voffA); PG8_STAGE(PG8_SA(0, 1), cA + hstep, voffA);
    if (wr == 1) PG8_BAR;
    PG8_WAIT_V(2); PG8_BAR;
    PG8_STAGE(PG8_SB(1, 0), cB + kstep, voffB); PG8_STAGE(PG8_SA(1, 0), cA + kstep, voffA); PG8_STAGE(PG8_SB(1, 1), cB + hstep + kstep, voffB);
    PG8_WAIT_V(6); PG8_BAR;
    for (;;) {
        const bool has_next = S.next(ui + 1, nxt);
        const char* nA = has_next ? (const char*)g.A + (size_t)nxt.pm * tstep : cA; const char* nB = has_next ? (const char*)g.Bt + (size_t)nxt.pn * tstep : cB;
        for (int t = 0; t < nt; t += 2) {
            const bool last = (t == nt - 2);
            const char* a1 = cA + (size_t)(t + 1) * kstep;
            const char* a2 = last ? nA : cA + (size_t)(t + 2) * kstep; const char* b2 = last ? nB : cB + (size_t)(t + 2) * kstep;
            const char* a3 = a2 + kstep; const char* b3 = b2 + kstep;
            if (last && has_next) S.a_ready(nxt);
            PG8_LDB(B0, 0, 0); PG8_LDB(B1, 0, 1); PG8_SCHED; PG8_LDA(At, 0, 0); PG8_STAGE(PG8_SA(1, 1), a1 + hstep, voffA);
            PG8_WAIT_V(8); PG8_WAIT_L(0); PG8_BAR; PG8_MMA(0, 0, At, B0); PG8_MMA(0, 1, At, B1); PG8_BAR; PG8_SCHED;
            PG8_LDA(At, 0, 1); PG8_STAGE(PG8_SB(0, 0), b2, voffB); PG8_STAGE(PG8_SB(0, 1), b2 + hstep, voffB); PG8_STAGE(PG8_SA(0, 0), a2, voffA);
            PG8_WAIT_V(8); PG8_WAIT_L(0); PG8_BAR; PG8_MMA(1, 0, At, B0); PG8_MMA(1, 1, At, B1); PG8_BAR; PG8_SCHED;
            PG8_LDB(B0, 1, 0); PG8_LDB(B1, 1, 1); PG8_SCHED; PG8_LDA(At, 1, 0); PG8_STAGE(PG8_SA(0, 1), a2 + hstep, voffA);
            PG8_WAIT_V(8); PG8_WAIT_L(0); PG8_BAR; PG8_MMA(0, 0, At, B0); PG8_MMA(0, 1, At, B1); PG8_BAR; PG8_SCHED;
            PG8_LDA(At, 1, 1); PG8_STAGE(PG8_SB(1, 0), b3, voffB); PG8_STAGE(PG8_SB(1, 1), b3 + hstep, voffB); PG8_STAGE(PG8_SA(1, 0), a3, voffA);
            PG8_WAIT_V(8); PG8_WAIT_L(0); PG8_BAR; PG8_MMA(1, 0, At, B0); PG8_MMA(1, 1, At, B1); PG8_BAR; PG8_SCHED;
        }
        if constexpr (ALIGN_EPI) { if (wr == 0) PG8_BAR; }
        if constexpr (F8) asm volatile("s_nop 15\n\ts_nop 15" ::: "memory");
        E(acc, cur, wr, wc, fr, fq); S.done(cur);
        if (!has_next) break;
#pragma unroll
        for (int a = 0; a < 2; ++a)
#pragma unroll
            for (int b = 0; b < 2; ++b)
#pragma unroll
                for (int m = 0; m < 4; ++m)
#pragma unroll
                    for (int n = 0; n < 2; ++n) acc[a][b][m][n] = (f32x4){0.f, 0.f, 0.f, 0.f};
        cur = nxt; cA = nA; cB = nB; ++ui;
        if constexpr (ALIGN_EPI) { if (wr == 1) PG8_BAR; }
    }
    PG8_WAIT_V(0);
    if constexpr (!ALIGN_EPI) { if (wr == 0) PG8_BAR; }
    PG8_BAR;
#undef PG8_SA
#undef PG8_SB
#undef PG8_STAGE
#undef PG8_LDA
#undef PG8_H
#undef PG8_LDB
#undef PG8_MMA
#undef PG8_WAIT_V
#undef PG8_WAIT_L
#undef PG8_BAR
#undef PG8_SCHED
}
}


namespace att {
constexpr int D = 128, ASTR = 1024;
constexpr float SCALE = 0.08838834764831845f, THR = 8.f, NEGBIG = -3.0e38f;
constexpr int NW = 8, QBLK = 32, KVBLK = 64, QB = NW * QBLK;
constexpr int SHM_V = KVBLK * D * 2, SHM_K = KVBLK * D * 2;
constexpr int LDS_BYTES = 2 * SHM_V + 2 * SHM_K + NW * 64 * 4;
constexpr size_t PART_O_BYTES = (size_t)QB * D * 2, PART_ML_BYTES = (size_t)QB * 2 * 4;
#define KSWZ(row, colB) ((row) * 256 + ((colB) ^ (((row) & 7) << 4)))
#define SBAR() __builtin_amdgcn_sched_barrier(0)
__device__ __forceinline__ int v_st(int k, int c) { const int kk = (k & ~0xC) | ((k & 4) << 1) | ((k & 8) >> 1); return ((kk >> 3) * 4 + (c >> 5)) * 512 + ((kk & 7) * 32 + (c & 31)) * 2; }
__device__ __forceinline__ int v_rd_base(int lane) { return ((lane & 3) << 3) | (((lane >> 2) & 3) << 6) | (((lane >> 4) & 1) << 5) | (((lane >> 5) & 1) << 8); }
constexpr int v_rd_off(int d0, int ks, int half) { return d0 * 512 + ks * 4096 + half * 2048; }
__device__ __forceinline__ int crow(int r, int hi) { return (r & 3) + 8 * (r >> 2) + 4 * hi; }
__device__ __forceinline__ h16x8 ld8(const f16_t* p) { return *reinterpret_cast<const h16x8*>(p); }
__device__ __forceinline__ float sgprf(float x) { return __uint_as_float(__builtin_amdgcn_readfirstlane(__float_as_uint(x))); }
__device__ __forceinline__ void pinit(f32x16& p0, f32x16& p1, unsigned mlo, unsigned mhi, float sl, float s5, float s32, float base, int hi) {
    const unsigned a = mlo >> (4 * hi), b = mhi >> (4 * hi);
    float v = base, w = base + s32;
    const unsigned NB_ = __float_as_uint(NEGBIG);
#pragma unroll
    for (int r = 0; r < 16; ++r) { const int c = (r & 3) + 8 * (r >> 2);
        const unsigned ma = (unsigned)__builtin_amdgcn_sbfe((int)a, c, 1), mb = (unsigned)__builtin_amdgcn_sbfe((int)b, c, 1);
        p0[r] = __uint_as_float((__float_as_uint(v) & ma) | (NB_ & ~ma));
        p1[r] = __uint_as_float((__float_as_uint(w) & mb) | (NB_ & ~mb));
        if ((r & 3) == 3) { v += s5; w += s5; } else { v += sl; w += sl; } }
}
__device__ __forceinline__ void partialSM(f32x16& p0, f32x16& p1, float& m_reg, float& mn, float& alpha) {
    float pmax = p0[0];
#pragma unroll
    for (int r = 1; r < 16; ++r) pmax = fmaxf(pmax, p0[r]);
#pragma unroll
    for (int r = 0; r < 16; ++r) pmax = fmaxf(pmax, p1[r]);
    { auto rr = __builtin_amdgcn_permlane32_swap(__float_as_uint(pmax), __float_as_uint(pmax), false, false);
      pmax = fmaxf(__uint_as_float(rr[0]), __uint_as_float(rr[1])); }
    constexpr float C2 = 1.4426950408889634f * SCALE;
    if (__builtin_expect(__all((pmax - m_reg) * SCALE <= THR), 1)) { mn = m_reg; alpha = 1.f; }
    else { mn = fmaxf(m_reg, pmax); alpha = __builtin_amdgcn_exp2f((m_reg - mn) * C2); m_reg = mn; }
    const float mnL = -mn * C2;
#pragma unroll
    for (int r = 0; r < 16; ++r) p0[r] = fmaf(p0[r], C2, mnL);
#pragma unroll
    for (int r = 0; r < 16; ++r) p1[r] = fmaf(p1[r], C2, mnL);
#pragma unroll
    for (int r = 0; r < 16; ++r) p0[r] = __builtin_amdgcn_exp2f(p0[r]);
}
__device__ __forceinline__ void finishSM(f32x16& p0, f32x16& p1, float alpha, float& l_reg, h16x8& pa0, h16x8& pa1, h16x8& pa2, h16x8& pa3) {
#pragma unroll
    for (int r = 0; r < 16; ++r) p1[r] = __builtin_amdgcn_exp2f(p1[r]);
    float ps = 0;
#pragma unroll
    for (int r = 0; r < 16; ++r) ps += p0[r];
#pragma unroll
    for (int r = 0; r < 16; ++r) ps += p1[r];
    { auto rr = __builtin_amdgcn_permlane32_swap(__float_as_uint(ps), __float_as_uint(ps), false, false);
      ps = __uint_as_float(rr[0]) + __uint_as_float(rr[1]); }
    l_reg = l_reg * alpha + ps;
#define PK4(P, B_, OUT) do { unsigned a0 = pk_h2(P[B_+0], P[B_+1]), a1 = pk_h2(P[B_+2], P[B_+3]);                          \
        unsigned b0 = pk_h2(P[B_+4], P[B_+5]), b1 = pk_h2(P[B_+6], P[B_+7]);                                             \
        auto r0 = __builtin_amdgcn_permlane32_swap(a0, b0, false, false); auto r1 = __builtin_amdgcn_permlane32_swap(a1, b1, false, false); \
        u32x4 w = {r0[0], r1[0], r0[1], r1[1]}; OUT = __builtin_bit_cast(h16x8, w); } while (0)
    PK4(p0, 0, pa0); PK4(p0, 8, pa1); PK4(p1, 0, pa2); PK4(p1, 8, pa3);
#undef PK4
}
template <int KB>
__device__ __forceinline__ void qkt(f32x16& p0, f32x16& p1, const char* K_lds, int r32, int hi, const h16x8* qr) {
    const char* kb[4];
#pragma unroll
    for (int dd = 0; dd < 4; ++dd) kb[dd] = K_lds + KB * SHM_K + KSWZ(r32, (dd * 16 + hi * 8) * 2);
#pragma unroll
    for (int d0 = 0; d0 < 8; ++d0) { const char* a = kb[d0 & 3] + (d0 >> 2) * 128;
        h16x8 b0 = *reinterpret_cast<const h16x8*>(a);
        h16x8 b1 = *reinterpret_cast<const h16x8*>(a + 32 * 256);
        p0 = __builtin_amdgcn_mfma_f32_32x32x16_f16(b0, qr[d0], p0, 0, 0, 0);
        p1 = __builtin_amdgcn_mfma_f32_32x32x16_f16(b1, qr[d0], p1, 0, 0, 0); }
}
template <int VB>
__device__ __forceinline__ void pv_tile(f32x16* o, int vb0, h16x8 pa0, h16x8 pa1, h16x8 pa2, h16x8 pa3) {
#define TRRD(dst, off) asm volatile("ds_read_b64_tr_b16 %0, %1 offset:%2" : "=&v"(dst) : "v"(vb0), "i"(off) : "memory")
#define CAT8(l, h) __builtin_bit_cast(h16x8, (s16x8){l[0], l[1], l[2], l[3], h[0], h[1], h[2], h[3]})
#define PV_D0(d0) do { s16x4 l0, l1, l2, l3, h0, h1, h2, h3; constexpr int b_ = VB * SHM_V + v_rd_off(d0, 0, 0); \
        TRRD(l0, b_); TRRD(h0, b_ + 2048); TRRD(l1, b_ + 4096); TRRD(h1, b_ + 6144); TRRD(l2, b_ + 8192); TRRD(h2, b_ + 10240); TRRD(l3, b_ + 12288); TRRD(h3, b_ + 14336); \
        asm volatile("s_waitcnt lgkmcnt(0)" ::: "memory"); SBAR();   \
        o[d0] = __builtin_amdgcn_mfma_f32_32x32x16_f16(pa0, CAT8(l0, h0), o[d0], 0, 0, 0);   \
        o[d0] = __builtin_amdgcn_mfma_f32_32x32x16_f16(pa1, CAT8(l1, h1), o[d0], 0, 0, 0);   \
        o[d0] = __builtin_amdgcn_mfma_f32_32x32x16_f16(pa2, CAT8(l2, h2), o[d0], 0, 0, 0);   \
        o[d0] = __builtin_amdgcn_mfma_f32_32x32x16_f16(pa3, CAT8(l3, h3), o[d0], 0, 0, 0); } while (0)
    PV_D0(0); PV_D0(1); PV_D0(2); PV_D0(3);
#undef PV_D0
#undef CAT8
#undef TRRD
}
struct BlockRef { int h, qb, j0, NT, slot; };
struct Ptrs { const f16_t* Q; const f16_t* K; const f16_t* V; f16_t* O; const unsigned long long* M; unsigned char* PART; };
struct Seam { h16x8 qr[8]; h16x8 st_v0, st_v1, st_k0, st_k1; };
#define ROW(p, k0, rr) ((p) + (size_t)((k0) + (rr)) * ASTR + sc)
#define VMW() asm volatile("s_waitcnt vmcnt(0)" ::: "memory")
#define VMWN(n) asm volatile("s_waitcnt vmcnt(%0)" :: "i"(n) : "memory")
#define SLOAD_H(Kp, Vp, k0) do { S.st_v0 = ld8(ROW(Vp, k0, sr)); S.st_v1 = ld8(ROW(Vp, k0, 32 + sr));              \
                         S.st_k0 = ld8(ROW(Kp, k0, sr)); S.st_k1 = ld8(ROW(Kp, k0, 32 + sr)); } while (0)
#define SWRITE_HK(bf) do { *(h16x8*)(K_lds + (bf) * SHM_K + kws) = S.st_k0; *(h16x8*)(K_lds + (bf) * SHM_K + kws + 32 * 256) = S.st_k1; } while (0)
#define SWRITE_HV(bf) do { *(h16x8*)(V_lds + (bf) * SHM_V + vst0) = S.st_v0; *(h16x8*)(V_lds + (bf) * SHM_V + vst1) = S.st_v1; } while (0)
#define SWRITE_H(bf) do { SWRITE_HV(bf); SWRITE_HK(bf); } while (0)
__device__ __forceinline__ void att_prime(const BlockRef& cur, const Ptrs& P, char* lds, Seam& S, int wid) {
    const int lane = lane_id(), tid = wid * 64 + lane, r32 = lane & 31, hi = lane >> 5;
    const int sr = tid >> 4, sc = (tid & 15) * 8, kws = KSWZ(sr, sc * 2); char* K_lds = lds + 2 * SHM_V;
#pragma unroll
    for (int d0 = 0; d0 < 8; ++d0) S.qr[d0] = ld8(P.Q + (size_t)(cur.qb * QB + wid * QBLK + r32) * ASTR + cur.h * D + d0 * 16 + hi * 8);
    SLOAD_H(P.K + cur.h * D, P.V + cur.h * D, cur.j0 * KVBLK); VMW(); SWRITE_HK(0);
    __syncthreads();
}
__device__ __forceinline__ void att_block(const BlockRef& cur, const BlockRef& nxt, const Ptrs& P, char* lds, Seam& S, int wid) {
    const int lane = lane_id(), tid = wid * 64 + lane, r32 = lane & 31, hi = lane >> 5;
    const int NT = cur.NT, j0 = cur.j0;
    const int qrow = cur.qb * QB + wid * QBLK + r32;
    const float sl = __uint_as_float(__builtin_amdgcn_readfirstlane(__float_as_uint(exp2f(-(float)(cur.h + 1)) * (1.0f / SCALE))));
    char* V_lds = lds; char* K_lds = lds + 2 * SHM_V;
    float* ws = (float*)(lds + 2 * SHM_V + 2 * SHM_K) + wid * 64; float* li_l = ws, * al_l = ws + 32;
    float m_reg = -1e30f, l_reg = 0; f32x16 o[4] = {};
    const int sr = tid >> 4, sc = (tid & 15) * 8, vst0 = v_st(sr, sc), vst1 = v_st(32 + sr, sc), kws = KSWZ(sr, sc * 2);
    const int vb0 = (int)(uintptr_t)V_lds + v_rd_base(lane);
    const f16_t* Kh = P.K + cur.h * D; const f16_t* Vh = P.V + cur.h * D;
    const float s5 = sgprf(sl * 5.0f), s32 = sgprf(sl * 32.0f);
    const float sl64 = sl * 64.0f, base0 = -sl * (float)(qrow - 4 * hi - j0 * KVBLK);
#define RESC(a) do { if (__any((a) < 1.f)) { if (hi == 0) al_l[r32] = (a); asm volatile("s_waitcnt lgkmcnt(0)" ::: "memory");              \
                     for (int d_ = 0; d_ < 4; ++d_) for (int r = 0; r < 16; ++r) o[d_][r] *= al_l[crow(r, hi)]; } } while (0)
#define KBASE(t) ((j0 + (t)) * KVBLK)
#define MLOAD(t) (P.M[(size_t)(j0 + (t)) * SEQ + qrow])
#define PINIT(PX0, PX1, mw, t) pinit(PX0, PX1, (unsigned)(mw), (unsigned)((mw) >> 32), sl, s5, s32, fmaf((float)(t), sl64, base0), hi)
    constexpr int NQL = 8;
#define SEAM_K0() do { VMWN(NQL); SWRITE_HK(0); SBAR(); } while (0)
    f32x16 pA0, pA1, pB0, pB1; float mnA, mnB, alA, alB; h16x8 pa0, pa1, pa2, pa3;
    unsigned long long mwc = MLOAD(0);
    SWRITE_HV(0); SBAR();
    SLOAD_H(Kh, Vh, KBASE(1));
    SBAR(); PINIT(pA0, pA1, mwc, 0); mwc = MLOAD(1); qkt<0>(pA0, pA1, K_lds, r32, hi, S.qr);
    partialSM(pA0, pA1, m_reg, mnA, alA);
    VMWN(1); SWRITE_H(1);
    __syncthreads();
#define HALF_STEP(PX0, PX1, mnX, alX, PY0, PY1, alY, t, KB, VB, SB) do {                                                      \
        SBAR(); PINIT(PX0, PX1, mwc, t); if ((t) + 1 < NT) mwc = MLOAD((t) + 1);                                              \
        qkt<KB>(PX0, PX1, K_lds, r32, hi, S.qr);                                                                               \
        finishSM(PY0, PY1, alY, l_reg, pa0, pa1, pa2, pa3); SBAR();                                                           \
        if ((t) + 1 < NT) { SLOAD_H(Kh, Vh, KBASE((t) + 1)); SBAR(); }                                                         \
        pv_tile<VB>(o, vb0, pa0, pa1, pa2, pa3); partialSM(PX0, PX1, m_reg, mnX, alX);                                        \
        __syncthreads();                                                                                                      \
        if ((t) + 1 < NT) { VMW(); SWRITE_H(SB); }                                                                            \
        RESC(alX); __syncthreads(); } while (0)
    for (int t = 1; t + 1 < NT; t += 2) {
        HALF_STEP(pB0, pB1, mnB, alB, pA0, pA1, alA, t, 1, 0, 0);
        HALF_STEP(pA0, pA1, mnA, alA, pB0, pB1, alB, t + 1, 0, 1, 1);
    }
    const bool even = (NT & 1) == 0;
    if (even) { SBAR(); PINIT(pB0, pB1, mwc, NT - 1); qkt<1>(pB0, pB1, K_lds, r32, hi, S.qr); SBAR(); }
    SLOAD_H(P.K + nxt.h * D, P.V + nxt.h * D, nxt.j0 * KVBLK); SBAR();
#pragma unroll
    for (int d0 = 0; d0 < 8; ++d0) S.qr[d0] = ld8(P.Q + (size_t)(nxt.qb * QB + wid * QBLK + r32) * ASTR + nxt.h * D + d0 * 16 + hi * 8);
    SBAR();
    finishSM(pA0, pA1, alA, l_reg, pa0, pa1, pa2, pa3); SBAR();
    pv_tile<0>(o, vb0, pa0, pa1, pa2, pa3);
    if (even) { partialSM(pB0, pB1, m_reg, mnB, alB); __syncthreads(); RESC(alB);
        finishSM(pB0, pB1, alB, l_reg, pa0, pa1, pa2, pa3); SBAR(); pv_tile<1>(o, vb0, pa0, pa1, pa2, pa3); }
    SBAR(); SEAM_K0();
    if (hi == 0) li_l[r32] = l_reg; asm volatile("s_waitcnt lgkmcnt(0)" ::: "memory");
    float rli[16];
#pragma unroll
    for (int r = 0; r < 16; ++r) { const float lv = li_l[crow(r, hi)]; rli[r] = lv > 0.f ? __builtin_amdgcn_rcpf(lv) : 0.f; }
    f16_t* Ow; int ostr;
    if (cur.slot >= 0) { unsigned char* pb = P.PART + (size_t)cur.slot * (PART_O_BYTES + PART_ML_BYTES); Ow = (f16_t*)pb + (size_t)(wid * QBLK) * D; ostr = D;
        if (hi == 0) { float* PML = (float*)(pb + PART_O_BYTES); PML[(wid * QBLK + r32) * 2] = m_reg; PML[(wid * QBLK + r32) * 2 + 1] = l_reg; } }
    else { Ow = P.O + (size_t)(cur.qb * QB + wid * QBLK) * ASTR + cur.h * D; ostr = ASTR; }
    if (MIX_F8 && cur.slot < 0) {
        unsigned char* O8 = (unsigned char*)P.O + (size_t)(cur.qb * QB + wid * QBLK) * ASTR + cur.h * D;
#pragma unroll
        for (int r = 0; r < 16; ++r) { const int orow = crow(r, hi);
#pragma unroll
            for (int d0 = 0; d0 < 4; ++d0) { const float v = o[d0][r] * rli[r];
                const float v1 = swz_xor<1>(v), v2 = swz_xor<2>(v), v3 = swz_xor<2>(v1);
                if ((r32 & 3) == 0) *(unsigned*)(O8 + (size_t)orow * ASTR + d0 * 32 + r32) = pk_f8x4(v, v1, v2, v3); } }
    } else {
#pragma unroll
    for (int r = 0; r < 16; ++r) { const int orow = crow(r, hi);
#pragma unroll
        for (int d0 = 0; d0 < 4; ++d0) { const float v = o[d0][r] * rli[r];
            const float vn = swz_xor<1>(v);
            if ((r32 & 1) == 0) *(unsigned*)(Ow + (size_t)orow * ostr + d0 * 32 + r32) = pk_h2(v, vn); } }
    }
    __syncthreads();
#undef RESC
#undef KBASE
#undef MLOAD
#undef PINIT
#undef SEAM_K0
#undef HALF_STEP
}
#undef ROW
#undef VMW
#undef VMWN
#undef SLOAD_H
#undef SWRITE_HK
#undef SWRITE_HV
#undef SWRITE_H
constexpr int SPLIT_T = 48, MAX_UNITS = 2048, MAXP = 6; constexpr float MARGIN = 17.0f;
constexpr int T_ORDER = MAX_UNITS * 16, T_COST = T_ORDER + MAX_UNITS * 2, T_SC = T_COST + MAX_UNITS * 2, T_CNT = T_SC + 8192, T_GT = T_CNT + MAX_UNITS * 4, T_TK = T_GT + 256;
__device__ __forceinline__ int build_units(LAS unsigned char* lds, const unsigned* NEED, int tid) {
    LAS u32x4* tab = (LAS u32x4*)lds; LAS unsigned short* order = (LAS unsigned short*)(lds + T_ORDER); LAS unsigned short* cost = (LAS unsigned short*)(lds + T_COST);
    LAS unsigned* sc = (LAS unsigned*)(lds + T_SC);
    if (tid < 8) sc[tid] = 0u;
    __syncthreads();
    const int h = tid >> 6, qb = tid & 63, P0 = qb * QB, NTf = 4 * qb + 4;
    const int ks = P0 - (int)NEED[qb * 8 + h];
    int jlo = ks >= -1 ? ((ks + 1) >> 6) : 0; jlo = jlo > NTf - 4 ? NTf - 4 : jlo;
    const int n = NTf - jlo, parts = (n + SPLIT_T - 1) / SPLIT_T;
    {
        const int lane = tid & 63, wv = tid >> 6; const unsigned pa = (unsigned)parts, pb = parts > 1 ? (unsigned)parts : 0u;
        unsigned ia = pa, ib = pb;
#pragma unroll
        for (int o = 1; o < 64; o <<= 1) { const unsigned ta = __shfl_up(ia, o), tb = __shfl_up(ib, o); if (lane >= o) { ia += ta; ib += tb; } }
        if (lane == 63) { sc[16 + wv] = ia; sc[32 + wv] = ib; }
        __syncthreads();
        unsigned oa = 0, ob = 0, ta_ = 0, tb_ = 0;
#pragma unroll
        for (int w = 0; w < 8; ++w) { const unsigned xa = sc[16 + w], xb = sc[32 + w]; if (w < wv) { oa += xa; ob += xb; } ta_ += xa; tb_ += xb; }
        sc[64 + tid] = oa + ia - pa; sc[1024 + tid] = ob + ib - pb;
        if (tid == 0) { sc[2] = ta_; sc[3] = tb_; }
        __syncthreads();
    }
    const int u0 = (int)sc[64 + tid], s0 = (int)sc[1024 + tid], U = (int)sc[2];
    for (int pp = 0; pp < parts; ++pp) { const int a = jlo + (int)((long)n * pp / parts), b2 = jlo + (int)((long)n * (pp + 1) / parts);
        if (u0 + pp < MAX_UNITS) { tab[u0 + pp] = (u32x4){(unsigned)h | ((unsigned)qb << 16), (unsigned)a | ((unsigned)(b2 - a) << 16), (unsigned)pp | ((unsigned)parts << 16), (unsigned)(s0 + pp)};
            cost[u0 + pp] = (unsigned short)(b2 - a); } }
    __syncthreads();
    const int Uc = U < MAX_UNITS ? U : MAX_UNITS;
    for (int i = Uc + tid; i < ((Uc + 7) & ~7); i += NT) cost[i] = 0;
    __syncthreads();
    { LAS unsigned* cnt = (LAS unsigned*)(lds + T_CNT); LAS unsigned* gt = (LAS unsigned*)(lds + T_GT);
      for (int i = tid; i < (MAX_UNITS / 64) * 64; i += NT) cnt[i] = 0u;
      __syncthreads();
      for (int i = tid; i < Uc; i += NT) { const unsigned c = min((unsigned)cost[i], 63u); __hip_atomic_fetch_add(cnt + (i >> 6) * 64 + c, 1u, __ATOMIC_RELAXED, __HIP_MEMORY_SCOPE_WORKGROUP); }
      LDS_WAIT(); __syncthreads();
      if (tid < 64) { unsigned run = 0;
          for (int b = 0; b < MAX_UNITS / 64; ++b) { const unsigned v = cnt[b * 64 + tid]; cnt[b * 64 + tid] = run; run += v; }
          unsigned suf = run;
#pragma unroll
          for (int o = 1; o < 64; o <<= 1) { const unsigned t = __shfl_down(suf, o); if (tid + o < 64) suf += t; }
          gt[tid] = suf - run; }
      LDS_WAIT(); __syncthreads();
      for (int i = tid; i < ((Uc + 63) & ~63); i += NT) { const bool act = i < Uc; const unsigned c = act ? min((unsigned)cost[i], 63u) : 64u;
          unsigned long long m = ~0ull;
#pragma unroll
          for (int bit = 0; bit < 7; ++bit) { const bool on = ((c >> bit) & 1u) != 0u; const unsigned long long bl = __builtin_amdgcn_ballot_w64(on); m &= on ? bl : ~bl; }
          const int rin = (int)__builtin_popcountll(m & ((1ull << (tid & 63)) - 1ull));
          if (act) order[gt[c] + cnt[(i >> 6) * 64 + c] + rin] = (unsigned short)i; }
      LDS_WAIT(); __syncthreads(); }
    return Uc;
}
__device__ __forceinline__ BlockRef unit_ref(const LAS unsigned char* lds, int ticket) {
    const LAS u32x4* tab = (const LAS u32x4*)lds; const LAS unsigned short* order = (const LAS unsigned short*)(lds + T_ORDER);
    const u32x4 u = tab[order[ticket]];
    BlockRef r; r.h = (int)(u.x & 0xffffu); r.qb = (int)(u.x >> 16); r.j0 = (int)(u.y & 0xffffu); r.NT = (int)(u.y >> 16); r.slot = (u.z >> 16) > 1u ? (int)u.w : -1;
    r.h = __builtin_amdgcn_readfirstlane(r.h); r.qb = __builtin_amdgcn_readfirstlane(r.qb); r.j0 = __builtin_amdgcn_readfirstlane(r.j0); r.NT = __builtin_amdgcn_readfirstlane(r.NT); r.slot = __builtin_amdgcn_readfirstlane(r.slot);
    return r;
}
constexpr int TAB_OFF = 69632;
__device__ __forceinline__ int att_phase(int& U_out, char* lds_g, LAS unsigned char* lds, const f16_t* Q, const f16_t* K, const f16_t* V, f16_t* O, const unsigned long long* M, unsigned char* PART,
                                          const unsigned* NEED, unsigned* qhead, unsigned* UT, int bx, int tid, int wid) {
    const int U = build_units(lds + TAB_OFF, NEED, tid);
    if (bx == 0) { const LAS unsigned* t32 = (const LAS unsigned*)(lds + TAB_OFF);
        for (int i = tid; i < U * 4; i += NT) UT[4 + i] = t32[i];
        if (tid == 0) UT[0] = (unsigned)U; }
    LAS unsigned* tk = (LAS unsigned*)(lds + TAB_OFF + T_TK);
    if (tid == 0) { tk[0] = __hip_atomic_fetch_add(qhead, 1u, __ATOMIC_RELAXED, __HIP_MEMORY_SCOPE_AGENT); }
    __syncthreads();
    int ticket = (int)tk[0];
    U_out = U;
    if (ticket >= U) return ticket;
    const Ptrs P{Q, K, V, O, M, PART};
    BlockRef cur = unit_ref(lds + TAB_OFF, ticket);
    Seam S;
    att_prime(cur, P, lds_g, S, wid);
    int pend;
    for (;;) {
        if (wid == 0 && lane_id() == 0) tk[1] = __hip_atomic_fetch_add(qhead, 1u, __ATOMIC_RELAXED, __HIP_MEMORY_SCOPE_AGENT);
        __syncthreads();
        const int tn = (int)tk[1]; const bool last = tn >= U;
        const BlockRef nxt = last ? cur : unit_ref(lds + TAB_OFF, tn);
        att_block(cur, nxt, P, lds_g, S, wid);
        if (last) { pend = tn; break; }
        cur = nxt;
    }
    return pend;
}
__device__ __forceinline__ void att_combine(LAS unsigned char* lds, const unsigned* UT, const unsigned char* PART, f16_t* O, int gw, int ngw, int lane, int tid) {
    const int U = (int)UT[0]; constexpr float C2 = 1.4426950408889634f * SCALE;
    LAS u32x4* tab = (LAS u32x4*)lds;
    LAS unsigned short* sl = (LAS unsigned short*)(lds + MAX_UNITS * 16);
    LAS unsigned* cc = (LAS unsigned*)(lds + MAX_UNITS * 16 + MAX_UNITS * 2);
    const int wv = tid >> 6;
    for (int i = tid; i < U; i += NT) tab[i] = *(const u32x4*)(UT + 4 + 4 * i);
    LDS_WAIT(); __syncthreads();
    const int nch = (U + 63) >> 6;
    for (int c = wv; c < nch; c += NWAVES) { const int i = c * 64 + lane; bool f = false; if (i < U) { const u32x4 u = tab[i]; f = (u.z >> 16) > 1u && (u.z & 0xffffu) == 0u; }
        const unsigned long long bl = __builtin_amdgcn_ballot_w64(f); if (lane == 0) cc[c] = (unsigned)__builtin_popcountll(bl); }
    LDS_WAIT(); __syncthreads();
    if (tid < 64) { const unsigned v = tid < nch ? cc[tid] : 0u; unsigned inc = v;
#pragma unroll
        for (int o = 1; o < 64; o <<= 1) { const unsigned t = __shfl_up(inc, o); if (tid >= o) inc += t; }
        if (tid < nch) cc[64 + tid] = inc - v; if (tid == 63) cc[40] = inc; }
    LDS_WAIT(); __syncthreads();
    for (int c = wv; c < nch; c += NWAVES) { const int i = c * 64 + lane; bool f = false; if (i < U) { const u32x4 u = tab[i]; f = (u.z >> 16) > 1u && (u.z & 0xffffu) == 0u; }
        const unsigned long long bl = __builtin_amdgcn_ballot_w64(f);
        if (f) sl[cc[64 + c] + (unsigned)__builtin_popcountll(bl & ((1ull << lane) - 1ull))] = (unsigned short)i; }
    LDS_WAIT(); __syncthreads();
    const int S = (int)cc[40], NQ = S * 64;
    const int rq = lane >> 4, c8 = (lane & 15) * 8;
    for (int i0 = gw; i0 < NQ; i0 += 4 * ngw) {
        float mm[4][MAXP], ll[4][MAXP]; h16x8 vv[4][MAXP];
#pragma unroll
        for (int k = 0; k < 4; ++k) { const int i = min(i0 + k * ngw, NQ - 1); const u32x4 u = tab[sl[i >> 6]]; const int row = 4 * (i & 63) + rq, nparts = (int)(u.z >> 16), slot = (int)u.w;
#pragma unroll
            for (int pp = 0; pp < MAXP; ++pp) { const int pq = pp < nparts ? pp : 0; const unsigned char* bs = PART + (size_t)(slot + pq) * (PART_O_BYTES + PART_ML_BYTES); const f32x2 ml = *(const f32x2*)((const float*)(bs + PART_O_BYTES) + row * 2);
                mm[k][pp] = pp < nparts ? ml.x : -3.0e38f; ll[k][pp] = pp < nparts ? ml.y : 0.f; vv[k][pp] = *(const h16x8*)((const f16_t*)bs + (size_t)row * D + c8); } }
#pragma unroll
        for (int k = 0; k < 4; ++k) { const int i = i0 + k * ngw; if (i < NQ) { const u32x4 u = tab[sl[i >> 6]]; const int row = 4 * (i & 63) + rq, h = (int)(u.x & 0xffffu), qb = (int)(u.x >> 16);
            float Mx = mm[k][0];
#pragma unroll
            for (int pp = 1; pp < MAXP; ++pp) Mx = fmaxf(Mx, mm[k][pp]);
            float a[8] = {0.f, 0.f, 0.f, 0.f, 0.f, 0.f, 0.f, 0.f}; float lsum = 0.f;
#pragma unroll
            for (int pp = 0; pp < MAXP; ++pp) { const float w = __builtin_amdgcn_exp2f((mm[k][pp] - Mx) * C2) * ll[k][pp]; lsum += w;
#pragma unroll
                for (int e = 0; e < 8; ++e) a[e] = fmaf(w, (float)vv[k][pp][e], a[e]); }
            const float rl = 1.0f / lsum;
            if (MIX_F8) { u32x2 w8; w8.x = pk_f8x4(a[0] * rl, a[1] * rl, a[2] * rl, a[3] * rl); w8.y = pk_f8x4(a[4] * rl, a[5] * rl, a[6] * rl, a[7] * rl);
                *(u32x2*)((unsigned char*)O + (size_t)(qb * QB + row) * ASTR + h * D + c8) = w8; }
            else { u32x4 w; w.x = pk_h2(a[0] * rl, a[1] * rl); w.y = pk_h2(a[2] * rl, a[3] * rl); w.z = pk_h2(a[4] * rl, a[5] * rl); w.w = pk_h2(a[6] * rl, a[7] * rl);
                *(u32x4*)(O + (size_t)(qb * QB + row) * ASTR + h * D + c8) = w; } } }
    }
    __syncthreads();
}
}


__device__ __forceinline__ const float* argp(int i) { const char __attribute__((address_space(4)))* k = (const char __attribute__((address_space(4)))*)__builtin_amdgcn_kernarg_segment_ptr(); asm volatile("" : "+s"(k)); return *(const float* const __attribute__((address_space(4)))*)(k + i * 8); }
namespace idx {
__device__ __forceinline__ float relu_i(float x) { return __int_as_float(max(__float_as_int(x), 0)); }
constexpr int CAPX = 512;
constexpr int BROW = 514;
constexpr int L_BITS = 0, L_HIST = 66048, L_KST = 98816, L_ST = 115200, L_W = 117248;
constexpr int ST_LO = 0, ST_INV = 32, ST_THR1 = 64, ST_ABOVE = 128, ST_SUM = 192, ST_SQ = 224, ST_BEST = 264, ST_NEED = 296, ST_WORDS = 304;
__host__ __device__ __forceinline__ size_t bins_off(int u) { const size_t M = (size_t)(u >> 3); return (size_t)8192 * (4 * M * (M + 1) + (size_t)(u & 7) * (M + 1)); }
constexpr size_t BINS_BYTES = (size_t)8192 * (4 * 64 * 65);
template <int MODE>
__device__ __forceinline__ void pass(LAS unsigned char* lds, const f16_t* KI, unsigned char* bins, int RS, int q0, int nkt, const h16x8 (&afr)[4][4], const h16x8 (&wh)[4][2], int wave, int lane) {
    LAS unsigned* hist = (LAS unsigned*)(lds + L_HIST); LAS float* stf = (LAS float*)(lds + L_ST);
    const int pg = wave & 3, kh = wave >> 2, n = lane & 31, hi = lane >> 5;
    const int key_l = 32 * kh + n, hbase = (8 * pg + hi) * 256;
    const unsigned boff = (unsigned)((8 * pg + hi) * RS + 4 * key_l);
    const unsigned koff = (unsigned)(key_l * IDIM + hi * 8) * 2u;
    h16x8 bn[4];
#pragma unroll
    for (int ks = 0; ks < 4; ++ks) bn[ks] = *(const h16x8*)((const char*)KI + (size_t)(ks * 32) + koff);
    unsigned bw[4] = {0u, 0u, 0u, 0u};
    float cinv[4] = {0.f, 0.f, 0.f, 0.f}, cnlo[4] = {0.f, 0.f, 0.f, 0.f};
    if (MODE == 1) {
#pragma unroll
        for (int p = 0; p < 4; ++p) { const int ql = 8 * pg + 2 * p + hi; cinv[p] = stf[ST_INV + ql]; cnlo[p] = -stf[ST_LO + ql] * cinv[p]; } }
#pragma unroll 1
    for (int kt = 0; kt < nkt; ++kt) {
        h16x8 bfr[4];
#pragma unroll
        for (int ks = 0; ks < 4; ++ks) bfr[ks] = bn[ks];
        const int key = 64 * kt + key_l;
        f32x16 acc_c = {};
#pragma unroll
        for (int ks = 0; ks < 4; ++ks) acc_c = __builtin_amdgcn_mfma_f32_32x32x16_f16(afr[0][ks], bfr[ks], acc_c, 0, 0, 0);
        __builtin_amdgcn_sched_barrier(0);
        if (MODE == 1 && kt > 0 && (kt & 3) == 0) {
#pragma unroll
            for (int p = 0; p < 4; ++p) { *(unsigned*)(bins + (size_t)(2 * p * RS + 256 * ((kt >> 2) - 1)) + boff) = bw[p]; bw[p] = 0u; } }
        if (kt + 1 < nkt) {
#pragma unroll
            for (int ks = 0; ks < 4; ++ks) bn[ks] = *(const h16x8*)((const char*)KI + (size_t)((kt + 1) * 8192 + ks * 32) + koff); }
        __builtin_amdgcn_sched_barrier(0);
#pragma unroll
        for (int p = 0; p < 4; ++p) {
            f32x16 acc_n = {};
            if (p < 3) {
#pragma unroll
                for (int ks = 0; ks < 4; ++ks) acc_n = __builtin_amdgcn_mfma_f32_32x32x16_f16(afr[p < 3 ? p + 1 : 3][ks], bfr[ks], acc_n, 0, 0, 0); }
            h16x8 rb0, rb1;
#pragma unroll
            for (int j = 0; j < 8; j += 2) { const f32x2 a01 = {acc_c[j], acc_c[j + 1]}, b01 = {acc_c[8 + j], acc_c[8 + j + 1]};
                const h16x2 ha = __builtin_convertvector(a01, h16x2), hb = __builtin_convertvector(b01, h16x2);
                rb0[j] = ha[0]; rb0[j + 1] = ha[1]; rb1[j] = hb[0]; rb1[j + 1] = hb[1]; }
            { const h16x8 z8 = {0, 0, 0, 0, 0, 0, 0, 0}, o8 = {1, 1, 1, 1, 1, 1, 1, 1}; rb0 = __builtin_elementwise_min(__builtin_elementwise_max(rb0, z8), o8); rb1 = __builtin_elementwise_min(__builtin_elementwise_max(rb1, z8), o8); }
            f32x4 yy = {0.f, 0.f, 0.f, 0.f};
            yy = __builtin_amdgcn_mfma_f32_16x16x32_f16(wh[p][0], rb0, yy, 0, 0, 0);
            yy = __builtin_amdgcn_mfma_f32_16x16x32_f16(wh[p][1], rb1, yy, 0, 0, 0);
            const float score = yy[0];
            const int ql = 8 * pg + 2 * p + hi;
            if (MODE == 0) {
                float s1 = score, s2 = score * score;
#pragma unroll
                for (int o = 1; o < 32; o <<= 1) { s1 += __shfl_xor(s1, o); s2 += __shfl_xor(s2, o); }
                if (n == 0) { __hip_atomic_fetch_add(stf + ST_SUM + ql, s1, __ATOMIC_RELAXED, __HIP_MEMORY_SCOPE_WORKGROUP); __hip_atomic_fetch_add(stf + ST_SQ + ql, s2, __ATOMIC_RELAXED, __HIP_MEMORY_SCOPE_WORKGROUP); }
            } else {
                const int b1 = (int)__builtin_amdgcn_fmed3f(fmaf(score, cinv[p], cnlo[p]), 0.f, 255.f);
                const unsigned valid = key <= q0 + ql ? 1u : 0u;
                __hip_atomic_fetch_add(hist + (hbase + b1) + p * 512, valid, __ATOMIC_RELAXED, __HIP_MEMORY_SCOPE_WORKGROUP);
                bw[p] |= (unsigned)b1 << (8 * (kt & 3));
            }
            acc_c = acc_n;
        }
    }
    if (MODE == 1) {
#pragma unroll
        for (int p = 0; p < 4; ++p) *(unsigned*)(bins + (size_t)(2 * p * RS + 256 * ((nkt - 1) >> 2)) + boff) = bw[p]; }
}
__device__ __forceinline__ void pass_pp(LAS unsigned char* lds, const f16_t* KI, unsigned char* bins, int RS, int q0, int nkt, const h16x8 (&afr)[4][4], const h16x8 (&wh)[4][2], int wave, int lane) {
    LAS unsigned* hist = (LAS unsigned*)(lds + L_HIST); LAS float* stf = (LAS float*)(lds + L_ST);
    const int pg = wave & 3, kh = wave >> 2, n = lane & 31, hi = lane >> 5;
    const int key_l = 32 * kh + n, hbase = (8 * pg + hi) * 256;
    const unsigned boff = (unsigned)((8 * pg + hi) * RS + 4 * key_l);
    const unsigned koff = (unsigned)(key_l * IDIM + hi * 8) * 2u;
    h16x8 bn[4];
#pragma unroll
    for (int ks = 0; ks < 4; ++ks) bn[ks] = *(const h16x8*)((const char*)KI + (size_t)(ks * 32) + koff);
    unsigned bw[4] = {0u, 0u, 0u, 0u};
    float cinv[4], cnlo[4];
#pragma unroll
    for (int p = 0; p < 4; ++p) { const int ql = 8 * pg + 2 * p + hi; cinv[p] = stf[ST_INV + ql]; cnlo[p] = -stf[ST_LO + ql] * cinv[p]; }
    if (kh == 1) __builtin_amdgcn_s_barrier();
#pragma unroll 1
    for (int kt = 0; kt < nkt; ++kt) {
        h16x8 bfr[4];
#pragma unroll
        for (int ks = 0; ks < 4; ++ks) bfr[ks] = bn[ks];
        f32x16 acc[4];
#pragma unroll
        for (int ks = 0; ks < 4; ++ks) acc[0] = __builtin_amdgcn_mfma_f32_32x32x16_f16(afr[0][ks], bfr[ks], ks == 0 ? (f32x16){} : acc[0], 0, 0, 0);
        __builtin_amdgcn_sched_barrier(0);
        if (kt > 0 && (kt & 3) == 0) {
#pragma unroll
            for (int p = 0; p < 4; ++p) { *(unsigned*)(bins + (size_t)(2 * p * RS + 256 * ((kt >> 2) - 1)) + boff) = bw[p]; bw[p] = 0u; } }
        if (kt + 1 < nkt) {
#pragma unroll
            for (int ks = 0; ks < 4; ++ks) bn[ks] = *(const h16x8*)((const char*)KI + (size_t)((kt + 1) * 8192 + ks * 32) + koff); }
        __builtin_amdgcn_sched_barrier(0);
#pragma unroll
        for (int p = 1; p < 4; ++p)
#pragma unroll
            for (int ks = 0; ks < 4; ++ks) acc[p] = __builtin_amdgcn_mfma_f32_32x32x16_f16(afr[p][ks], bfr[ks], ks == 0 ? (f32x16){} : acc[p], 0, 0, 0);
        __builtin_amdgcn_sched_barrier(0);
        __builtin_amdgcn_s_barrier();
        __builtin_amdgcn_sched_barrier(0);
        const int key = 64 * kt + key_l;
        float score[4];
#pragma unroll
        for (int p = 0; p < 4; ++p) {
            h16x8 rb0, rb1;
#pragma unroll
            for (int j = 0; j < 8; j += 2) { const f32x2 a01 = {acc[p][j], acc[p][j + 1]}, b01 = {acc[p][8 + j], acc[p][8 + j + 1]};
                const h16x2 ha = __builtin_convertvector(a01, h16x2), hb = __builtin_convertvector(b01, h16x2);
                rb0[j] = ha[0]; rb0[j + 1] = ha[1]; rb1[j] = hb[0]; rb1[j + 1] = hb[1]; }
            { const h16x8 z8 = {0, 0, 0, 0, 0, 0, 0, 0}, o8 = {1, 1, 1, 1, 1, 1, 1, 1}; rb0 = __builtin_elementwise_min(__builtin_elementwise_max(rb0, z8), o8); rb1 = __builtin_elementwise_min(__builtin_elementwise_max(rb1, z8), o8); }
            f32x4 yy = {0.f, 0.f, 0.f, 0.f};
            yy = __builtin_amdgcn_mfma_f32_16x16x32_f16(wh[p][0], rb0, yy, 0, 0, 0);
            yy = __builtin_amdgcn_mfma_f32_16x16x32_f16(wh[p][1], rb1, yy, 0, 0, 0);
            score[p] = yy[0]; }
#pragma unroll
        for (int p = 0; p < 4; ++p) { const int ql = 8 * pg + 2 * p + hi;
            const int b1 = (int)__builtin_amdgcn_fmed3f(fmaf(score[p], cinv[p], cnlo[p]), 0.f, 255.f);
            const unsigned valid = key <= q0 + ql ? 1u : 0u;
            __hip_atomic_fetch_add(hist + (hbase + b1) + p * 512, valid, __ATOMIC_RELAXED, __HIP_MEMORY_SCOPE_WORKGROUP);
            bw[p] |= (unsigned)b1 << (8 * (kt & 3)); }
        __builtin_amdgcn_sched_barrier(0);
        __builtin_amdgcn_s_barrier();
        __builtin_amdgcn_sched_barrier(0);
    }
    if (kh == 0) __builtin_amdgcn_s_barrier();
#pragma unroll
    for (int p = 0; p < 4; ++p) *(unsigned*)(bins + (size_t)(2 * p * RS + 256 * ((nkt - 1) >> 2)) + boff) = bw[p];
}
__device__ __forceinline__ void scan_hist(const LAS unsigned* h, int need, int lane, int& thr, int& above, int& inbin) {
    const u32x4 c = *(const LAS u32x4*)(h + 4 * lane);
    const int s = (int)(c.x + c.y + c.z + c.w);
    int v = s;
#pragma unroll
    for (int o = 1; o < 64; o <<= 1) { const int t = __shfl_down(v, o); if (lane + o < 64) v += t; }
    int run = v - s;
    int mythr = -1, myab = 0, myin = 0;
    if (run < need && run + s >= need) {
        const int cc[4] = {(int)c.x, (int)c.y, (int)c.z, (int)c.w};
#pragma unroll
        for (int k = 3; k >= 0; --k) { if (mythr < 0 && run + cc[k] >= need) { mythr = 4 * lane + k; myab = run; myin = cc[k]; } run += cc[k]; }
    }
    const unsigned long long bal = __ballot(mythr >= 0);
    const int src = bal ? (int)__builtin_ctzll(bal) : 0;
    thr = __shfl(mythr, src); above = __shfl(myab, src); inbin = __shfl(myin, src);
    if (!bal) { thr = 0; above = 0; inbin = 0; }
}
__device__ __forceinline__ void resolve(LAS unsigned char* lds, const f16_t* QI, const f16_t* KI, const float* WI, unsigned long long* MASK, unsigned char* BINS, unsigned* NEED, int q0_, int tid, int wave, int lane);
__device__ __forceinline__ void unit(LAS unsigned char* lds, const f16_t* QI, const f16_t* KI, const float* WI, unsigned long long* MASK, unsigned char* BINS, unsigned* NEED, int q0, int tid, int wave, int lane) {
    LAS unsigned* bits = (LAS unsigned*)(lds + L_BITS); LAS unsigned* hist = (LAS unsigned*)(lds + L_HIST); LAS unsigned* st = (LAS unsigned*)(lds + L_ST);
    LAS float* stf = (LAS float*)(lds + L_ST);
    const int Q0 = q0 & ~255, ntile = (Q0 + 256) / 64;
    if (q0 < 256) {
        for (int i = tid; i < ntile * 32; i += NT) { const int j = i >> 5, ql = i & 31, t = q0 + ql; const int k0 = 64 * j;
            const unsigned long long w = t >= k0 + 63 ? ~0ull : (t < k0 ? 0ull : ((1ull << (t - k0 + 1)) - 1ull));
            MASK[(size_t)j * SEQ + q0 + ql] = w; }
        return;
    }
    __syncthreads();
    for (int i = tid; i < 32768 / 16; i += NT) ((LAS u32x4*)(lds + L_HIST))[i] = (u32x4){0u, 0u, 0u, 0u};
    if (tid < ST_WORDS) st[tid] = 0u;
    const int pg = wave & 3, r = lane & 31, hi2 = lane >> 5;
    h16x8 afr[4][4]; h16x8 wh[4][2];
#pragma unroll
    for (int p = 0; p < 4; ++p) { const int q = q0 + 8 * pg + 2 * p + (r >> 4);
#pragma unroll
        for (int ks = 0; ks < 4; ++ks) afr[p][ks] = *(const h16x8*)(QI + (size_t)q * 1024 + (r & 15) * 64 + ks * 16 + hi2 * 8) * (_Float16)0.00390625f;
#pragma unroll
        for (int e = 0; e < 2; ++e) { const int kq = lane >> 4, hb = kq >> 1;
            const float* wr = WI + (size_t)(q0 + 8 * pg + 2 * p + e) * IH + 4 * hb; const f32x4 wa = *(const f32x4*)wr, wb = *(const f32x4*)(wr + 8);
            const bool on = (lane & 15) == 8 * e + 4 * (kq & 1);
            wh[p][e] = on ? (h16x8){(_Float16)wa[0], (_Float16)wa[1], (_Float16)wa[2], (_Float16)wa[3], (_Float16)wb[0], (_Float16)wb[1], (_Float16)wb[2], (_Float16)wb[3]} : (h16x8){0, 0, 0, 0, 0, 0, 0, 0}; }
    }
    LDS_WAIT(); __syncthreads();
    const int nkt = q0 / 64 + 1, RS = Q0 + 256;
    unsigned char* bins = BINS + bins_off(q0 >> 5);
    pass<0>(lds, KI, bins, RS, q0, 1, afr, wh, wave, lane);
    LDS_WAIT(); __syncthreads();
    if (tid < 32) { const float mu = stf[ST_SUM + tid] * (1.0f / 64), var = fmaxf(stf[ST_SQ + tid] * (1.0f / 64) - mu * mu, 1e-20f), sd = sqrtf(var);
        stf[ST_LO + tid] = mu - 4.0f * sd; stf[ST_INV + tid] = 25.6f / sd; }
    LDS_WAIT(); __syncthreads();
    pass_pp(lds, KI, bins, RS, q0, nkt, afr, wh, wave, lane);
    asm volatile("s_waitcnt vmcnt(0) lgkmcnt(0)" ::: "memory"); __syncthreads();
#pragma unroll 1
    for (int i = 0; i < 4; ++i) { const int ql = 4 * wave + i; int thr, above, inbin; scan_hist(hist + ql * 256, TOPK, lane, thr, above, inbin);
        if (lane == 0) { st[ST_THR1 + ql] = (unsigned)thr; st[ST_ABOVE + ql] = (unsigned)above; } }
    LDS_WAIT(); __syncthreads();
    resolve(lds, QI, KI, WI, MASK, BINS, NEED, q0, tid, wave, lane);
}
__device__ __forceinline__ void resolve(LAS unsigned char* lds, const f16_t* QI, const f16_t* KI, const float* WI, unsigned long long* MASK, unsigned char* BINS, unsigned* NEED, int q0_, int tid, int wave, int lane) {
    int q0 = q0_; asm volatile("" : "+s"(q0));
    LAS unsigned* bits = (LAS unsigned*)(lds + L_BITS); LAS unsigned* st = (LAS unsigned*)(lds + L_ST);
    const int Q0 = q0 & ~255, ntile = (Q0 + 256) / 64, RS = Q0 + 256;
    unsigned char* bins = BINS + bins_off(q0 >> 5);
    LAS unsigned* candk = (LAS unsigned*)(lds + L_HIST + wave * 4096); LAS float* cands = (LAS float*)(candk + CAPX);
    const int h = lane & 15;
#pragma unroll 1
    for (int i = 0; i < 4; ++i) { const int ql = 4 * wave + i, t = q0 + ql; const int thr = (int)st[ST_THR1 + ql], need = TOPK - (int)st[ST_ABOVE + ql];
        const unsigned* row = (const unsigned*)(bins + (size_t)ql * RS);
        int cnt = 0;
        const int ngrp = RS >> 8;
        const unsigned thrw = (unsigned)thr * 0x01010101u;
        const int nfull = ngrp - 1;
        for (int g0 = 0; g0 < nfull; g0 += 16) {
            unsigned wv[16];
#pragma unroll
            for (int u8 = 0; u8 < 16; ++u8) { const int gc = min(g0 + u8, nfull - 1); wv[u8] = row[gc * 64 + lane]; }
            unsigned accA = 0u, accB = 0u;
#pragma unroll
            for (int u8 = 0; u8 < 16; ++u8) { const int gi = g0 + u8; if (gi < nfull) { const unsigned w = wv[u8];
                const unsigned x = w ^ thrw; const bool hasc = ((x - 0x01010101u) & ~x & 0x80808080u) != 0u;
                const bool anyc = __builtin_amdgcn_ballot_w64(hasc) != 0ull;
#pragma unroll
                for (int b = 0; b < 4; ++b) { const int v = (int)((w >> (8 * b)) & 255u);
                    const unsigned long long m = __builtin_amdgcn_ballot_w64(v > thr);
                    const int mi = 4 * u8 + b;
                    const unsigned mlo = (unsigned)m, mhi = (unsigned)(m >> 32);
                    if (mi < 32) asm volatile("s_nop 4\n\tv_writelane_b32 %0, %1, %3\n\ts_nop 1\n\tv_writelane_b32 %0, %2, %4" : "+v"(accA) : "s"(mlo), "s"(mhi), "n"(2 * (mi & 31)), "n"(2 * (mi & 31) + 1));
                    else asm volatile("s_nop 4\n\tv_writelane_b32 %0, %1, %3\n\ts_nop 1\n\tv_writelane_b32 %0, %2, %4" : "+v"(accB) : "s"(mlo), "s"(mhi), "n"(2 * (mi & 31)), "n"(2 * (mi & 31) + 1));
                    if (anyc) { const unsigned long long cm = __builtin_amdgcn_ballot_w64(v == thr);
                        if (cm) { const int pre = (int)__builtin_popcountll(cm & ((1ull << lane) - 1ull));
                            if (v == thr && cnt + pre < CAPX) candk[cnt + pre] = (unsigned)(256 * gi + 64 * b + lane);
                            cnt += (int)__builtin_popcountll(cm); } } } } }
            bits[ql * BROW + 8 * g0 + lane] = accA; bits[ql * BROW + 8 * g0 + 64 + lane] = accB; }
        {
            const int gi = nfull; const unsigned w = row[gi * 64 + lane];
#pragma unroll
            for (int b = 0; b < 4; ++b) { const int v = (int)((w >> (8 * b)) & 255u), key = 256 * gi + 64 * b + lane; const bool valid = key <= t;
                const unsigned long long m = __ballot(valid && v > thr);
                if (lane == 0) *(LAS unsigned long long*)(bits + ql * BROW + 2 * (4 * gi + b)) = m;
                const unsigned long long cm = __ballot(valid && v == thr);
                if (cm) { const int pre = (int)__builtin_popcountll(cm & ((1ull << lane) - 1ull));
                    if (valid && v == thr && cnt + pre < CAPX) candk[cnt + pre] = (unsigned)key;
                    cnt += (int)__builtin_popcountll(cm); } } }
        cnt = min(cnt, CAPX);
        LDS_WAIT();
        { const int n16 = lane & 15, kq = lane >> 4;
          const h16x8 qa0 = *(const h16x8*)(QI + (size_t)t * 1024 + n16 * 64 + 8 * kq), qa1 = *(const h16x8*)(QI + (size_t)t * 1024 + n16 * 64 + 32 + 8 * kq);
          const f32x4 w4 = *(const f32x4*)(WI + (size_t)t * IH + 4 * kq);
          for (int e0 = 0; e0 < cnt; e0 += 16) { const int e = min(e0 + n16, cnt - 1); const unsigned key = candk[e];
              const h16x8 kb0 = *(const h16x8*)(KI + (size_t)key * IDIM + 8 * kq), kb1 = *(const h16x8*)(KI + (size_t)key * IDIM + 32 + 8 * kq);
              f32x4 dd = {0.f, 0.f, 0.f, 0.f};
              dd = __builtin_amdgcn_mfma_f32_16x16x32_f16(qa0, kb0, dd, 0, 0, 0);
              dd = __builtin_amdgcn_mfma_f32_16x16x32_f16(qa1, kb1, dd, 0, 0, 0);
              float sc2 = fmaxf(dd[0], 0.f) * w4[0] + fmaxf(dd[1], 0.f) * w4[1] + fmaxf(dd[2], 0.f) * w4[2] + fmaxf(dd[3], 0.f) * w4[3];
              sc2 += __shfl_xor(sc2, 16); sc2 += __shfl_xor(sc2, 32);
              if (kq == 0 && e0 + n16 < cnt) cands[e0 + n16] = sc2; } }
        LDS_WAIT();
        for (int e0 = 0; e0 < cnt; e0 += 64) { const int e = e0 + lane; const bool act = e < cnt; const float s0 = act ? cands[e] : 0.f; const unsigned k0 = act ? candk[e] : 0u;
            int rk = 0;
            for (int f = 0; f < cnt; ++f) { const float sf = cands[f]; const unsigned kf = candk[f]; rk += (sf > s0 || (sf == s0 && kf < k0)) ? 1 : 0; }
            if (act && rk < need) __hip_atomic_fetch_or(bits + ql * BROW + (k0 >> 5), 1u << (k0 & 31), __ATOMIC_RELAXED, __HIP_MEMORY_SCOPE_WORKGROUP); }
        LDS_WAIT();
        {
            int best = 0;
#pragma unroll
            for (int k = 0; k < 4; ++k) { const int j = lane + 64 * k; if (j < ntile) { const unsigned long long w = *(const LAS unsigned long long*)(bits + ql * BROW + 2 * j); if (w) best = max(best, 64 * j + 63 - (int)__builtin_clzll(w)); } }
#pragma unroll
            for (int o = 1; o < 64; o <<= 1) best = max(best, __shfl_xor(best, o));
            if (lane == 0) st[ST_BEST + ql] = (unsigned)best; }
    }
    LDS_WAIT(); __syncthreads();
    {
        const int ln = lane_id(), hh = ln >> 3, sub = ln & 7;
    const f16_t* QN = QI - (size_t)3 * SEQ * 1024; const f16_t* KN = QI - (size_t)2 * SEQ * 1024;
    const float* g_q = argp(13); const float* g_k = argp(14);
    float Bq;
    { const int l5 = ln & 31;
      float a = fmaxf(fmaxf(fabsf(g_q[l5]), fabsf(g_q[l5 + 32])), fmaxf(fabsf(g_q[l5 + 64]), fabsf(g_q[l5 + 96]))), b = fmaxf(fmaxf(fabsf(g_k[l5]), fabsf(g_k[l5 + 32])), fmaxf(fabsf(g_k[l5 + 64]), fabsf(g_k[l5 + 96])));
      a = fmaxf(a, swz_xor<1>(a)); b = fmaxf(b, swz_xor<1>(b)); a = fmaxf(a, swz_xor<2>(a)); b = fmaxf(b, swz_xor<2>(b)); a = fmaxf(a, swz_xor<4>(a)); b = fmaxf(b, swz_xor<4>(b));
      a = fmaxf(a, swz_xor<8>(a)); b = fmaxf(b, swz_xor<8>(b)); a = fmaxf(a, swz_xor<16>(a)); b = fmaxf(b, swz_xor<16>(b));
      Bq = 11.3137085f * 1.004f * a * b; }
        h16x8 qa[4], qb[4], ka[4], kb[4]; int bst[4];
#pragma unroll
        for (int i = 0; i < 4; ++i) { const int ql = 4 * wave + i, t = q0 + ql; bst[i] = (int)st[ST_BEST + ql];
            const size_t qo = (size_t)t * 1024 + hh * 128 + sub * 16, ko = (size_t)bst[i] * 1024 + hh * 128 + sub * 16;
            qa[i] = *(const h16x8*)(QN + qo); qb[i] = *(const h16x8*)(QN + qo + 8); ka[i] = *(const h16x8*)(KN + ko); kb[i] = *(const h16x8*)(KN + ko + 8); }
        int need = 0;
#pragma unroll
        for (int i = 0; i < 4; ++i) { const int t = q0 + 4 * wave + i; float dot = 0.f;
#pragma unroll
            for (int j = 0; j < 8; ++j) { dot = fmaf((float)qa[i][j], (float)ka[i][j], dot); dot = fmaf((float)qb[i][j], (float)kb[i][j], dot); }
            dot += swz_xor<1>(dot); dot += swz_xor<2>(dot); dot += swz_xor<4>(dot);
            const float wdw = (float)(t - bst[i]) + (Bq - dot * att::SCALE + att::MARGIN + 0.05f) * (float)(2 << hh);
            need = max(need, (int)ceilf(wdw) - (t - Q0)); }
        if (sub == 0) __hip_atomic_fetch_max(st + ST_NEED + hh, (unsigned)need, __ATOMIC_RELAXED, __HIP_MEMORY_SCOPE_WORKGROUP);
    }
    for (int i = tid; i < ntile * 32; i += NT) { const int j = i >> 5, ql = i & 31;
        const unsigned lo = bits[ql * BROW + 2 * j], hi = bits[ql * BROW + 2 * j + 1];
        MASK[(size_t)j * SEQ + q0 + ql] = ((unsigned long long)hi << 32) | lo; }
    LDS_WAIT(); __syncthreads();
    if (tid < 8) __hip_atomic_fetch_max(NEED + (q0 >> 8) * 8 + tid, st[ST_NEED + tid], __ATOMIC_RELAXED, __HIP_MEMORY_SCOPE_AGENT);
}
}

constexpr size_t MiB = 1u << 20;
constexpr size_t WS_CTL = 0, CTL_ZERO_BYTES = 64 * 1024;
constexpr size_t WS_ADAP = 1 * MiB;
constexpr size_t WS_ADA = 3 * MiB;
constexpr size_t WS_WFF = 4 * MiB;
constexpr size_t WS_WFFD = WS_WFF + (size_t)2 * DFF * DM * 2;
constexpr size_t WS_WIN = 70 * MiB;
constexpr size_t WS_WA = 556 * MiB, WS_WB = 560 * MiB, WS_WO = 564 * MiB;
constexpr size_t WS_NB = 128 * MiB;
constexpr size_t WS_HB = 192 * MiB;
constexpr size_t WS_Z6 = 192 * MiB;
constexpr size_t WS_GAB = 384 * MiB;
constexpr size_t WS_KI = 520 * MiB;
constexpr size_t WS_WI = 522 * MiB;
constexpr size_t WS_MASK = 524 * MiB;
constexpr size_t WS_X1H = 572 * MiB;
constexpr size_t WS_END = 636 * MiB;
constexpr size_t WS_WFF2 = 448 * MiB;
constexpr size_t WS_A8 = 112 * MiB;
constexpr size_t WS_BINS = 4 * MiB;
static_assert(WS_BINS + idx::BINS_BYTES <= 192 * MiB, "bins");
static_assert(WS_WFFD + (size_t)DM * DFF * 2 <= WS_WIN && WS_WIN + (size_t)INW_PAD * DM * 2 <= 128 * MiB && WS_HB + (size_t)SEQ * DFF * 2 <= WS_GAB, "ws map");

constexpr int LDS_BYTES = 160 * 1024;
constexpr int LDS_MISC = LDS_BYTES - 256;

#define XB_TMO      128
#define XB_XCNT(j)  (256  + 64 * (j))
#define XB_XSUB(j)  (1280 + 64 * (j))
#define XB_XGEN(j)  (2304 + 64 * (j))
#define XB_TOP      3328
#define XB_TOPGEN   3392
#define XCD_BAR_WORDS 3456
#define XB_SPIN_CAP (1u << 18)
__device__ __forceinline__ unsigned xb_ld(unsigned* p)              { return __hip_atomic_load(p, __ATOMIC_RELAXED, __HIP_MEMORY_SCOPE_AGENT); }
__device__ __forceinline__ unsigned xb_add(unsigned* p, unsigned v) { return __hip_atomic_fetch_add(p, v, __ATOMIC_RELAXED, __HIP_MEMORY_SCOPE_AGENT); }
__device__ __forceinline__ unsigned xb_xcc_id() { return (unsigned)__builtin_amdgcn_s_getreg((3 << 11) | 20) & 0xFu; }
#define XB_SPIN(cond, bar) do { unsigned _sp = 0; while (cond) { __builtin_amdgcn_s_sleep(1); \
    if ((++_sp & 255u) == 0u) { if (xb_ld(&(bar)[XB_TMO])) break; if (_sp > XB_SPIN_CAP) { atomicAdd(&(bar)[XB_TMO], 1u); break; } } } } while (0)
struct XcdBarrier { unsigned* bar; unsigned x; volatile LAS unsigned* st; };
__device__ __forceinline__ XcdBarrier xcd_barrier_post(unsigned* bar, volatile LAS unsigned* st, bool t0) {
    XcdBarrier b; b.bar = bar; b.x = xb_xcc_id(); b.st = st;
    if (t0) (void)xb_add(&bar[XB_XCNT(b.x)], 1u);
    return b;
}
__device__ __forceinline__ void xcd_barrier_complete(unsigned* bar, unsigned x, unsigned& nloc, unsigned& nx) {
    const unsigned G = gridDim.x * gridDim.y * gridDim.z;
    unsigned sum, cnt, mine, sp = 0u;
    for (;;) {
        sum = 0u; cnt = 0u; mine = 0u;
#pragma unroll
        for (unsigned j = 0; j < 16; ++j) { const unsigned c = xb_ld(&bar[XB_XCNT(j)]); sum += c; cnt += (c > 0u) ? 1u : 0u; mine = (j == x) ? c : mine; }
        if (sum == G) break;
        __builtin_amdgcn_s_sleep(1);
        if ((++sp & 255u) == 0u) { if (xb_ld(&bar[XB_TMO])) break; if (sp > XB_SPIN_CAP) { atomicAdd(&bar[XB_TMO], 1u); break; } }
    }
    nloc = mine > 0u ? mine : 1u; nx = cnt > 0u ? cnt : 1u;
}
__device__ __forceinline__ void xcd_barrier(const XcdBarrier& b, bool t0) {
    asm volatile("s_waitcnt vmcnt(0)" ::: "memory");
    __syncthreads();
    if (t0) {
        unsigned* bar = b.bar;
        __builtin_amdgcn_s_waitcnt(0);
        unsigned nloc = b.st[0], nx = b.st[1];
        if (nloc == 0u) { xcd_barrier_complete(bar, b.x, nloc, nx); b.st[0] = nloc; b.st[1] = nx; }
        const unsigned old = xb_add(&bar[XB_XSUB(b.x)], 1u);
        const unsigned gen = old / nloc;
        if (old + 1u == (gen + 1u) * nloc) {
            __builtin_amdgcn_fence(__ATOMIC_RELEASE, "agent");
            asm volatile("s_waitcnt vmcnt(0)" ::: "memory");
            const unsigned og = xb_add(&bar[XB_TOP], 1u);
            const unsigned tg = og / nx;
            if (og + 1u == (tg + 1u) * nx) xb_add(&bar[XB_TOPGEN], 1u);
            else XB_SPIN(xb_ld(&bar[XB_TOPGEN]) == tg, bar);
            __builtin_amdgcn_fence(__ATOMIC_ACQUIRE, "agent");
            xb_add(&bar[XB_XGEN(b.x)], 1u);
            asm volatile("s_waitcnt vmcnt(0)" ::: "memory");
        } else {
            XB_SPIN(xb_ld(&bar[XB_XGEN(b.x)]) == gen, bar);
            __builtin_amdgcn_fence(__ATOMIC_ACQUIRE, "agent");
            asm volatile("s_waitcnt vmcnt(0)" ::: "memory");
        }
    }
    __syncthreads();
}

__device__ __forceinline__ float wave_sum(float v) {
#pragma unroll
    for (int o = 1; o < 64; o <<= 1) v += __shfl_xor(v, o);
    return v;
}

__device__ __forceinline__ void ada_partial(const float* c, const float* w_ada, float* part, int b, int tid) {
    if (b >= 256) return;
    const int s = b >> 4, cr = b & 15;
    if (tid < 288) {
        const float* wp = w_ada + (size_t)(s * 128) * NADA + cr * 1152 + tid * 4;
        f32x4 a = {0.f, 0.f, 0.f, 0.f};
#pragma unroll 32
        for (int i = 0; i < 128; ++i) { const float ci = c[s * 128 + i]; const float sc = silu_f(ci); const f32x4 w = __builtin_nontemporal_load((const f32x4*)(wp + (size_t)i * NADA)); a += w * sc; }
        *(f32x4*)(part + (size_t)s * NADA + cr * 1152 + tid * 4) = a;
    }
}
__device__ __forceinline__ float ada_col(const float* part, const float* b_ada, int col) {
    float a = b_ada[col];
#pragma unroll
    for (int s = 0; s < 16; ++s) a += part[(size_t)s * NADA + col];
    return a;
}

__device__ __forceinline__ void transpose_item(const float* W, int ldw, int K, int k0, int n_src0, int nv, f16_t* WT, int dst_row0, LAS float* scr, int lane) {
    const int cg = lane & 7, rr = lane >> 3;
#pragma unroll
    for (int it = 0; it < 8; ++it) { const int kk = it * 8 + rr; f32x4 v = {0.f, 0.f, 0.f, 0.f};
        const float* src = W + (size_t)(k0 + kk) * ldw + n_src0 + cg * 4;
        if (cg * 4 + 3 < nv) v = __builtin_nontemporal_load((const f32x4*)src);
        else { if (cg * 4 + 0 < nv) v[0] = src[0]; if (cg * 4 + 1 < nv) v[1] = src[1]; if (cg * 4 + 2 < nv) v[2] = src[2]; }
        *(LAS f32x4*)(scr + kk * 36 + cg * 4) = v; }
    LDS_WAIT(); asm volatile("" ::: "memory");
    const int c = lane & 7;
#pragma unroll
    for (int j = 0; j < 4; ++j) { const int n = (lane >> 3) + 8 * j; const LAS float* s = scr + (8 * c) * 36 + n;
        u32x4 o; o.x = pk_h2(s[0 * 36], s[1 * 36]); o.y = pk_h2(s[2 * 36], s[3 * 36]); o.z = pk_h2(s[4 * 36], s[5 * 36]); o.w = pk_h2(s[6 * 36], s[7 * 36]);
        if (n < nv) *(u32x4*)(WT + (size_t)(dst_row0 + n) * K + k0 + 8 * c) = o; }
    LDS_WAIT(); asm volatile("" ::: "memory");
}
__device__ __forceinline__ void transpose_item_f8(const float* W, int ldw, int rowb, int k0, int n_src0, f8_t* WT, int dst_row0, float mul, LAS float* scr, int lane) {
    const int cg = lane & 7, rr = lane >> 3;
#pragma unroll
    for (int it = 0; it < 8; ++it) { const int kk = it * 8 + rr; *(LAS f32x4*)(scr + kk * 36 + cg * 4) = __builtin_nontemporal_load((const f32x4*)(W + (size_t)(k0 + kk) * ldw + n_src0 + cg * 4)); }
    LDS_WAIT(); asm volatile("" ::: "memory");
    const int n = lane >> 1, hf = lane & 1; const LAS float* sp = scr + (32 * hf) * 36 + n;
    u32x4 o0, o1;
    o0.x = pk_f8x4(sp[0 * 36] * mul, sp[1 * 36] * mul, sp[2 * 36] * mul, sp[3 * 36] * mul); o0.y = pk_f8x4(sp[4 * 36] * mul, sp[5 * 36] * mul, sp[6 * 36] * mul, sp[7 * 36] * mul);
    o0.z = pk_f8x4(sp[8 * 36] * mul, sp[9 * 36] * mul, sp[10 * 36] * mul, sp[11 * 36] * mul); o0.w = pk_f8x4(sp[12 * 36] * mul, sp[13 * 36] * mul, sp[14 * 36] * mul, sp[15 * 36] * mul);
    o1.x = pk_f8x4(sp[16 * 36] * mul, sp[17 * 36] * mul, sp[18 * 36] * mul, sp[19 * 36] * mul); o1.y = pk_f8x4(sp[20 * 36] * mul, sp[21 * 36] * mul, sp[22 * 36] * mul, sp[23 * 36] * mul);
    o1.z = pk_f8x4(sp[24 * 36] * mul, sp[25 * 36] * mul, sp[26 * 36] * mul, sp[27 * 36] * mul); o1.w = pk_f8x4(sp[28 * 36] * mul, sp[29 * 36] * mul, sp[30 * 36] * mul, sp[31 * 36] * mul);
    f8_t* dst = WT + (size_t)(dst_row0 + n) * rowb + k0 + 32 * hf;
    *(u32x4*)dst = o0; *(u32x4*)(dst + 16) = o1;
    LDS_WAIT(); asm volatile("" ::: "memory");
}
template <bool F8> __device__ __forceinline__ void convert_ffn_gu(const float* wg, const float* wu, void* Wt, LAS float* scr, int gw, int ngw, int lane) {
    constexpr int I_GU = (DM / 64) * (DFF / 32);
    for (int it = gw; it < 2 * I_GU; it += ngw) { const int which = it >= I_GU, r = it - which * I_GU, kb = r / (DFF / 32), nb = r % (DFF / 32), n0 = nb * 32;
        const int drow = 256 * (n0 / 128) + (n0 % 128) + which * 128;
        if (F8) transpose_item_f8(which ? wu : wg, DFF, DM, kb * 64, n0, (f8_t*)Wt, drow, W_GU_MUL, scr, lane);
        else transpose_item(which ? wu : wg, DFF, DM, kb * 64, n0, 32, (f16_t*)Wt, drow, scr, lane); }
}
template <bool F8> __device__ __forceinline__ void convert_ffn_d(const float* wd, void* Wd, LAS float* scr, int gw, int ngw, int lane) {
    constexpr int I_D = (DFF / 64) * (DM / 32);
    for (int it = gw; it < I_D; it += ngw) { const int kb = it / (DM / 32), nb = it % (DM / 32);
        if (F8) transpose_item_f8(wd, DM, DFF8, kb * 64, nb * 32, (f8_t*)Wd, nb * 32, W_D_MUL, scr, lane);
        else transpose_item(wd, DM, DFF, kb * 64, nb * 32, 32, (f16_t*)Wd, nb * 32, scr, lane); }
    if (F8) for (int r = gw; r < DM; r += ngw) if (lane < (DFF8 - DFF) / 16) *(u32x4*)((f8_t*)Wd + (size_t)r * DFF8 + DFF + 16 * lane) = (u32x4){0u, 0u, 0u, 0u};
}
template <bool F8> __device__ __forceinline__ void convert_down_in_tail(const float* wd, void* Wd, LAS unsigned char* lds, int bx, int G, int wave, int lane) {
    LAS float* scr = (LAS float*)(lds + wave * 9216);
    const int nfull = (SEQ / 256) * (2 * DFF / 256) % G;
    if (nfull > 0 && G - nfull >= 32) { if (bx >= nfull) convert_ffn_d<F8>(wd, Wd, scr, (bx - nfull) * NWAVES + wave, (G - nfull) * NWAVES, lane); }
    else convert_ffn_d<F8>(wd, Wd, scr, bx * NWAVES + wave, G * NWAVES, lane);
}
template <bool W8, bool M8> __device__ __forceinline__ void convert_mid(const float* w_in, const float* w_a, const float* w_b, const float* w_o, void* Win, f16_t* Win16, void* Wa, void* Wb, void* Wo, LAS float* scr, int gw, int ngw, int lane) {
    constexpr int NB_IN = 192 + 3 + 128;
    constexpr int I_IN = (DM / 64) * NB_IN, I_A = (SGW / 64) * (DM / 32), I_O = (DM / 64) * (DM / 32);
    for (int it = gw; it < I_IN + 2 * I_A + I_O; it += ngw) {
        if (it < I_IN) { const int kb = it / NB_IN, nb = it % NB_IN;
            if (!W8) {
                if (nb < 192) transpose_item(w_in, INW, DM, kb * 64, nb * 32, 32, (f16_t*)Win, nb * 32, scr, lane);
                else if (nb < 195) { const int j = nb - 192; transpose_item(w_in, INW, DM, kb * 64, 6144 + j * 32, j == 2 ? 16 : 32, (f16_t*)Win, 10240 + j * 32, scr, lane); }
                else { const int j = nb - 195; transpose_item(w_in, INW, DM, kb * 64, 6224 + j * 32, 32, (f16_t*)Win, 6144 + j * 32, scr, lane); } }
            else {
                if (nb < 160) transpose_item_f8(w_in, INW, DM, kb * 64, nb * 32, (f8_t*)Win, nb * 32, W_GU_MUL, scr, lane);
                else if (nb < 192) transpose_item(w_in, INW, DM, kb * 64, nb * 32, 32, Win16, (nb - 160) * 32, scr, lane);
                else if (nb < 195) { const int j = nb - 192; transpose_item(w_in, INW, DM, kb * 64, 6144 + j * 32, j == 2 ? 16 : 32, Win16, 1024 + j * 32, scr, lane); }
                else { const int j = nb - 195; transpose_item_f8(w_in, INW, DM, kb * 64, 6224 + j * 32, (f8_t*)Win, 5120 + j * 32, W_GU_MUL, scr, lane); } } }
        else if (it < I_IN + 2 * I_A) { const int r0 = it - I_IN, which = r0 >= I_A, r = r0 - which * I_A, kb = r / (DM / 32), nb = r % (DM / 32);
            if (M8) transpose_item_f8(which ? w_b : w_a, DM, SGW, kb * 64, nb * 32, (f8_t*)(which ? Wb : Wa), nb * 32, W_AB_MUL, scr, lane);
            else transpose_item(which ? w_b : w_a, DM, SGW, kb * 64, nb * 32, 32, (f16_t*)(which ? Wb : Wa), nb * 32, scr, lane); }
        else { const int r = it - I_IN - 2 * I_A, kb = r / (DM / 32), nb = r % (DM / 32);
            if (M8) transpose_item_f8(w_o, DM, DM, kb * 64, nb * 32, (f8_t*)Wo, nb * 32, W_GU_MUL, scr, lane);
            else transpose_item(w_o, DM, DM, kb * 64, nb * 32, 32, (f16_t*)Wo, nb * 32, scr, lane); }
    }
}

template <bool O8> __device__ __forceinline__ void norm_rows(const float* X, void* O, const LAS float* la, const LAS float* lsh, int gw, int ngw, int lane) {
    for (int m = gw; m < SEQ; m += ngw) {
        const f32x4* xr = (const f32x4*)(X + (size_t)m * DM) + lane;
        f32x4 v[8]; float s = 0.f;
#pragma unroll
        for (int j = 0; j < 8; ++j) { v[j] = __builtin_nontemporal_load(xr + 64 * j); s += (v[j].x * v[j].x + v[j].y * v[j].y) + (v[j].z * v[j].z + v[j].w * v[j].w); }
        const float r = 1.0f / sqrtf(wave_sum(s) * (1.0f / DM) + EPS);
#pragma unroll
        for (int j = 0; j < 8; ++j) { const f32x4 a = *(const LAS f32x4*)(la + 4 * lane + 256 * j), sh = *(const LAS f32x4*)(lsh + 4 * lane + 256 * j);
            const float y0 = v[j].x * r * a.x + sh.x, y1 = v[j].y * r * a.y + sh.y, y2 = v[j].z * r * a.z + sh.z, y3 = v[j].w * r * a.w + sh.w;
            if (O8) ((unsigned*)((f8_t*)O + (size_t)m * DM))[lane + 64 * j] = pk_f8x4(y0, y1, y2, y3);
            else { u32x2 w; w.x = pk_h2(y0, y1); w.y = pk_h2(y2, y3); ((u32x2*)((f16_t*)O + (size_t)m * DM))[lane + 64 * j] = w; } }
    }
}
template <bool O8, bool ALSO8 = false> __device__ __forceinline__ void norm_rows_h(const f16_t* X, void* O, const LAS float* la, const LAS float* lsh, int gw, int ngw, int lane, f8_t* O2 = nullptr) {
    for (int m = gw; m < SEQ; m += ngw) {
        const h16x8* xr = (const h16x8*)(X + (size_t)m * DM) + lane;
        float v[4][8]; float s = 0.f;
#pragma unroll
        for (int j = 0; j < 4; ++j) { const h16x8 h8 = xr[64 * j];
#pragma unroll
            for (int e = 0; e < 8; ++e) { v[j][e] = (float)h8[e]; s += v[j][e] * v[j][e]; } }
        const float r = 1.0f / sqrtf(wave_sum(s) * (1.0f / DM) + EPS);
#pragma unroll
        for (int j = 0; j < 4; ++j) { const LAS float* a = la + 8 * lane + 512 * j; const LAS float* sh = lsh + 8 * lane + 512 * j;
            const f32x4 a0 = *(const LAS f32x4*)a, a1 = *(const LAS f32x4*)(a + 4), s0 = *(const LAS f32x4*)sh, s1 = *(const LAS f32x4*)(sh + 4);
            float y[8]; y[0] = v[j][0] * r * a0.x + s0.x; y[1] = v[j][1] * r * a0.y + s0.y; y[2] = v[j][2] * r * a0.z + s0.z; y[3] = v[j][3] * r * a0.w + s0.w;
            y[4] = v[j][4] * r * a1.x + s1.x; y[5] = v[j][5] * r * a1.y + s1.y; y[6] = v[j][6] * r * a1.z + s1.z; y[7] = v[j][7] * r * a1.w + s1.w;
            if (O8) { u32x2 w; w.x = pk_f8x4(y[0], y[1], y[2], y[3]); w.y = pk_f8x4(y[4], y[5], y[6], y[7]); ((u32x2*)((f8_t*)O + (size_t)m * DM))[lane + 64 * j] = w; }
            else { u32x4 w; w.x = pk_h2(y[0], y[1]); w.y = pk_h2(y[2], y[3]); w.z = pk_h2(y[4], y[5]); w.w = pk_h2(y[6], y[7]); ((u32x4*)((f16_t*)O + (size_t)m * DM))[lane + 64 * j] = w;
                if (ALSO8) { u32x2 w8; w8.x = pk_f8x4(y[0], y[1], y[2], y[3]); w8.y = pk_f8x4(y[4], y[5], y[6], y[7]); ((u32x2*)(O2 + (size_t)m * DM))[lane + 64 * j] = w8; } } }
    }
}
__device__ __forceinline__ void zero_h_pad(f8_t* H8, int gw, int ngw, int lane) { for (int r = gw; r < SEQ; r += ngw) if (lane < (DFF8 - DFF) / 16) *(u32x4*)(H8 + (size_t)r * DFF8 + DFF + 16 * lane) = (u32x4){0u, 0u, 0u, 0u}; }

constexpr int SGU_LD = 136, SGU_TILE_B = 128 * SGU_LD * 2;
__device__ __forceinline__ void sgu_load_ws(LAS unsigned char* lds, const float* w_sp, int g, int tid) {
    const int i = tid >> 2, j0 = (tid & 3) * 32; const float* src = w_sp + ((size_t)g * 128 + i) * 128 + j0;
    LAS unsigned char* dst = lds + (i * SGU_LD + j0) * 2;
#pragma unroll
    for (int q = 0; q < 4; ++q) { const f32x4 a = *(const f32x4*)(src + 8 * q), b = *(const f32x4*)(src + 8 * q + 4); float v[8] = {a.x, a.y, a.z, a.w, b.x, b.y, b.z, b.w};
#pragma unroll
        for (int e = 0; e < 8; ++e) if (j0 + 8 * q + e > i) v[e] = 0.f;
        u32x4 w; w.x = pk_h2(v[0], v[1]); w.y = pk_h2(v[2], v[3]); w.z = pk_h2(v[4], v[5]); w.w = pk_h2(v[6], v[7]);
        *(LAS u32x4*)(dst + 16 * q) = w; }
}
__device__ __forceinline__ void sgu_unit(LAS unsigned char* lds, f16_t* U, f8_t* A8, const f16_t* V, const float* g_sgu, const float* b_sp, int n, int g, int tid, int wave, int lane) {
    LAS unsigned char* ws_l = lds; LAS unsigned char* vt_l = lds + SGU_TILE_B;
    {
        const int j = tid >> 2, c0 = (tid & 3) * 32; const f16_t* src = V + (size_t)(n * 128 + j) * 1024 + g * 128 + c0;
        float v[32];
#pragma unroll
        for (int q = 0; q < 4; ++q) { const h16x8 a = *(const h16x8*)(src + 8 * q);
#pragma unroll
            for (int e = 0; e < 8; ++e) v[8 * q + e] = (float)a[e]; }
        float s = 0.f;
#pragma unroll
        for (int e = 0; e < 32; ++e) s += v[e] * v[e];
        s += __shfl_xor(s, 1); s += __shfl_xor(s, 2);
        const float r = 1.0f / sqrtf(s * (1.0f / 128) + EPS);
        const float* gp = g_sgu + g * 128 + c0;
#pragma unroll
        for (int e = 0; e < 32; ++e) { const _Float16 hv = (_Float16)(v[e] * r * gp[e]); *(LAS _Float16*)(vt_l + ((c0 + e) * SGU_LD + j) * 2) = hv; }
    }
    LDS_WAIT(); __syncthreads();
    const int li = lane & 15, kq = lane >> 4;
    f32x4 acc[8];
#pragma unroll
    for (int cb = 0; cb < 8; ++cb) acc[cb] = (f32x4){0.f, 0.f, 0.f, 0.f};
#pragma unroll
    for (int ks = 0; ks < 4; ++ks) {
        const h16x8 wf = *(const LAS h16x8*)(ws_l + ((16 * wave + li) * SGU_LD + 32 * ks + 8 * kq) * 2);
#pragma unroll
        for (int cb = 0; cb < 8; ++cb) { const h16x8 vf = *(const LAS h16x8*)(vt_l + ((16 * cb + li) * SGU_LD + 32 * ks + 8 * kq) * 2);
            acc[cb] = __builtin_amdgcn_mfma_f32_16x16x32_f16(vf, wf, acc[cb], 0, 0, 0); }
    }
    {
        const int i = 16 * wave + li; const float bias = b_sp[g * 128 + i];
        f16_t* up = U + (size_t)(n * 128 + i) * 1024 + g * 128 + 4 * kq;
#pragma unroll
        for (int cb = 0; cb < 8; ++cb) { const h16x4 uu = *(const h16x4*)(up + 16 * cb);
            const float r0 = (float)uu[0] * (acc[cb][0] + bias), r1 = (float)uu[1] * (acc[cb][1] + bias), r2 = (float)uu[2] * (acc[cb][2] + bias), r3 = (float)uu[3] * (acc[cb][3] + bias);
            if (A8) *(unsigned*)(A8 + (size_t)(n * 128 + i) * 1024 + g * 128 + 4 * kq + 16 * cb) = pk_f8x4(r0, r1, r2, r3);
            else { u32x2 o; o.x = pk_h2(r0, r1); o.y = pk_h2(r2, r3); *(u32x2*)(up + 16 * cb) = o; } }
    }
    __syncthreads();
}

#define FRESH_IDS const int lane = lane_id(); const int wave = wave0; const int tid = wave0 * 64 + lane; const int gw = bx * NWAVES + wave; (void)tid; (void)lane; (void)wave; (void)gw;
struct Args { const float* in[24]; float* out; unsigned char* ws; int ph_lo, ph_hi; };
constexpr int N_PHASES = 15;

__global__ void __launch_bounds__(NT, 2) fwd_kernel(Args args) {
    extern __shared__ __attribute__((aligned(16))) unsigned char lds_raw[];
    LAS unsigned char* lds = (LAS unsigned char*)lds_raw;
    volatile LAS unsigned* MISC = (volatile LAS unsigned*)(lds + LDS_MISC);
    const int wave0 = __builtin_amdgcn_readfirstlane((int)threadIdx.x >> 6);
    const int lane = lane_id(), wave = wave0, tid = wave0 * 64 + lane;
    const int G = gridDim.x, bx = blockIdx.x;
    const int gw = bx * NWAVES + wave, ngw = G * NWAVES;
    unsigned char* ws = args.ws;
    unsigned* ctl = (unsigned*)(ws + WS_CTL);
    if (tid < 64) MISC[tid] = 0u;
    __syncthreads();
    XcdBarrier bar = xcd_barrier_post(ctl + 4096, MISC + 8, tid == 0);
    const int lo = args.ph_lo, hi = args.ph_hi;
#define IN(k) (lo <= (k) && (k) < hi)
#define SEAM(k) do { if (IN(k) && IN((k) + 1)) xcd_barrier(bar, wave0 == 0 && lane_id() == 0); } while (0)

    const float* x = argp(0); float* out = args.out;
    float* adap = (float*)(ws + WS_ADAP); float* ada = (float*)(ws + WS_ADA);
    f16_t* Wt = (f16_t*)(ws + WS_WFF); f16_t* Wd = (f16_t*)(ws + WS_WFFD);
    f16_t* NB = (f16_t*)(ws + WS_NB); f16_t* HB = (f16_t*)(ws + WS_HB); f16_t* X1H = (f16_t*)(ws + WS_X1H);

    if (IN(0)) {
        FRESH_IDS
        ada_partial(argp(1), argp(2), adap, bx, tid);
        LAS float* scr = (LAS float*)(lds + wave * 9216);
        convert_ffn_gu<FFN1_F8>(argp(5), argp(6), Wt, scr, gw, ngw, lane);
        convert_mid<WIN_F8, MIX_F8>(argp(9), argp(17), argp(18), argp(19), ws + WS_WIN, (f16_t*)(ws + WS_WIN + 20 * MiB), ws + WS_WA, ws + WS_WB, ws + WS_WO, scr, gw, ngw, lane);
    }
    SEAM(0);
    if (IN(1)) {
        FRESH_IDS
        LAS float* la = (LAS float*)lds; LAS float* lsh = la + DM;
        const float* g1 = argp(4);
        for (int c = tid; c < DM; c += NT) { const float sh = ada_col(adap, argp(3), c), sc = ada_col(adap, argp(3), DM + c); la[c] = g1[c] * (1.0f + sc); lsh[c] = sh; }
        for (int c = bx * NT + tid; c < NADA; c += G * NT) ada[c] = ada_col(adap, argp(3), c);
        __syncthreads();
        norm_rows<FFN1_F8>(x, NB, la, lsh, gw, ngw, lane);
        if (FFN1_F8) zero_h_pad((f8_t*)HB, gw, ngw, lane);
        __syncthreads();
    }
    SEAM(1);
    if (IN(2)) {
        FRESH_IDS
        if constexpr (FFN1_F8) { pg8::Gemm g{NB, Wt, SEQ, 2 * DFF, DM / 2, E8M0_GU, E8M0_1}; pg8::StaticOrder S; S.init(SEQ, 2 * DFF, G, bx);
            pg8::EpiSwiGLU<true> E{HB, DFF8}; pg8::gemm_phase<pg8::EpiSwiGLU<true>, pg8::StaticOrder, true, true>(lds, g, S, E, wave0); }
        else { pg8::Gemm g{NB, Wt, SEQ, 2 * DFF, DM, 0u, 0u}; pg8::StaticOrder S; S.init(SEQ, 2 * DFF, G, bx);
            pg8::EpiSwiGLU<false> E{HB, DFF}; pg8::gemm_phase<pg8::EpiSwiGLU<false>, pg8::StaticOrder>(lds, g, S, E, wave0); }
        convert_down_in_tail<FFN1_F8>(argp(7), Wd, lds, bx, G, wave, lane);
    }
    SEAM(2);
    if (IN(3)) {
        FRESH_IDS
        pg8::StaticOrder S; S.init(SEQ, DM, G, bx);
        pg8::EpiResidH<false, true> E{x, X1H, ada + 2 * DM, 0.5f, DM};
        if constexpr (FFN1_F8) { pg8::Gemm g{HB, Wd, SEQ, DM, DFF8 / 2, E8M0_DH, E8M0_1}; pg8::gemm_phase<pg8::EpiResidH<false, true>, pg8::StaticOrder, true, true>(lds, g, S, E, wave0); }
        else { pg8::Gemm g{HB, Wd, SEQ, DM, DFF, 0u, 0u}; pg8::gemm_phase<pg8::EpiResidH<false, true>, pg8::StaticOrder>(lds, g, S, E, wave0); }
    }
    SEAM(3);
    f16_t* Z6 = (f16_t*)(ws + WS_Z6); f16_t* GAB = (f16_t*)(ws + WS_GAB);
    f16_t* KI = (f16_t*)(ws + WS_KI); float* WI = (float*)(ws + WS_WI);
    f16_t* ZU = Z6, *ZV = Z6 + (size_t)1 * SEQ * 1024, *ZQ = Z6 + (size_t)2 * SEQ * 1024, *ZK = Z6 + (size_t)3 * SEQ * 1024, *ZVV = Z6 + (size_t)4 * SEQ * 1024, *ZQI = Z6 + (size_t)5 * SEQ * 1024;
    f16_t* AO = ZQI;
    if (IN(4)) {
        FRESH_IDS
        LAS float* la = (LAS float*)lds; LAS float* lsh = la + DM;
        const float* g2 = argp(8);
        for (int c = tid; c < DM; c += NT) { la[c] = g2[c] * (1.0f + ada[4 * DM + c]); lsh[c] = ada[3 * DM + c]; }
        __syncthreads();
        norm_rows_h<false, WIN_F8>(X1H, NB, la, lsh, gw, ngw, lane, (f8_t*)(ws + WS_MASK));
        __syncthreads();
    }
    SEAM(4);
    if (IN(5)) {
        FRESH_IDS
        if constexpr (WIN_F8) {
            { pg8::Gemm g{(const f16_t*)(ws + WS_MASK), (const f16_t*)(ws + WS_WIN), SEQ, 36 * 256, DM / 2, E8M0_GU, E8M0_1}; pg8::BalOrder S; S.init(SEQ, 36 * 256, G, bx);
              pg8::EpiWIN E{Z6, GAB, KI, WI, argp(15), argp(16), argp(13), argp(14), (LAS float*)(lds + 131072), 1};
              pg8::gemm_phase<pg8::EpiWIN, pg8::BalOrder, true, true>(lds, g, S, E, wave0); }
            { pg8::Gemm g{NB, (const f16_t*)(ws + WS_WIN + 20 * MiB), SEQ, 5 * 256, DM, 0u, 0u}; pg8::StaticOrder S; S.init(SEQ, 5 * 256, G, bx);
              pg8::EpiWIN E{Z6, GAB, KI, WI, argp(15), argp(16), argp(13), argp(14), (LAS float*)(lds + 131072), 2};
              pg8::gemm_phase<pg8::EpiWIN, pg8::StaticOrder>(lds, g, S, E, wave0); }
            if (EARLY_W2 && G == 256 && bx >= 128) {
                __syncthreads();
                LAS float* scr = (LAS float*)(lds + wave * 9216);
                convert_ffn_gu<FFN2_F8>(argp(21), argp(22), ws + WS_WFF2, scr, (bx - 128) * NWAVES + wave, (G - 128) * NWAVES, lane); }
        } else {
            pg8::Gemm g{NB, (const f16_t*)(ws + WS_WIN), SEQ, INW_PAD, DM, 0u, 0u}; pg8::StaticOrder S; S.init(SEQ, INW_PAD, G, bx);
            pg8::EpiWIN E{Z6, GAB, KI, WI, argp(15), argp(16), argp(13), argp(14), (LAS float*)(lds + 131072), 0};
            pg8::gemm_phase<pg8::EpiWIN, pg8::StaticOrder>(lds, g, S, E, wave0);
        }
    }
    SEAM(5);
    if (IN(7)) {
        const int nit = bx < 256 ? 2 * ((255 - bx) / G + 1) : 0;
#pragma unroll 1
        for (int it = 0; it < nit; ++it) { const int u0 = bx + (it >> 1) * G, u = (it & 1) ? 511 - u0 : u0;
            FRESH_IDS
            idx::unit(lds, ZQI, KI, WI, (unsigned long long*)(ws + WS_MASK), ws + WS_BINS, ctl + 8256, 32 * u, tid, wave, lane);
        }
    }
    SEAM(7);
    if (IN(8)) {
        FRESH_IDS
        int U; int tkt = att::att_phase(U, (char*)lds_raw, lds, ZQ, ZK, ZVV, AO, (const unsigned long long*)(ws + WS_MASK), ws + WS_BINS, ctl + 8256, ctl + 8192, ctl + 16384, bx, tid, wave0);
        LAS unsigned* tk = (LAS unsigned*)(lds + att::TAB_OFF + att::T_TK);
        int gl = -1;
        const int lane_ = lane_id(), tid_ = wave0 * 64 + lane_;
        __syncthreads();
        for (int si = tkt - U; si < (SEQ / 128) * 8; ) { const int g = si >> 7, n = si & 127;
            if (g != gl) { __syncthreads(); sgu_load_ws(lds, argp(11), g, tid_); gl = g; }
            unsigned tnx = 0u;
            if (tid_ == 0) tnx = __hip_atomic_fetch_add(ctl + 8192, 1u, __ATOMIC_RELAXED, __HIP_MEMORY_SCOPE_AGENT);
            sgu_unit(lds, ZU, MIX_F8 ? (f8_t*)(ws + WS_A8) : nullptr, ZV, argp(10), argp(12), n, g, tid_, wave0, lane_);
            if (tid_ == 0) tk[0] = tnx;
            __syncthreads();
            si = (int)tk[0] - U; }
    }
    SEAM(8);
    if (IN(9)) {
        FRESH_IDS
        att::att_combine(lds, ctl + 16384, ws + WS_BINS, AO, gw, ngw, lane, tid);
        pg8::StaticOrder S; S.init(SEQ, DM, G, bx);
        pg8::EpiBranch<false> E{GAB, NB, DM, nullptr};
        if constexpr (MIX_F8) { pg8::Gemm g{(const f16_t*)(ws + WS_A8), (const f16_t*)(ws + WS_WA), SEQ, DM, SGW / 2, E8M0_AB, E8M0_1}; pg8::gemm_phase<pg8::EpiBranch<false>, pg8::StaticOrder, true, true>(lds, g, S, E, wave0); }
        else { pg8::Gemm g{ZU, (const f16_t*)(ws + WS_WA), SEQ, DM, SGW, 0u, 0u}; pg8::gemm_phase<pg8::EpiBranch<false>, pg8::StaticOrder>(lds, g, S, E, wave0); }
    }
    SEAM(9);
    if (IN(10)) {
        FRESH_IDS
        pg8::StaticOrder S; S.init(SEQ, DM, G, bx);
        pg8::EpiBranch<true, MIX_F8> E{GATE_F8 ? (const f16_t*)((const f8_t*)GAB + (size_t)SEQ * DM) : GAB + (size_t)SEQ * DM, NB, DM, (f8_t*)ZV};
        if constexpr (MIX_F8) { pg8::Gemm g{AO, (const f16_t*)(ws + WS_WB), SEQ, DM, ATW / 2, E8M0_AB, E8M0_1}; pg8::gemm_phase<pg8::EpiBranch<true, MIX_F8>, pg8::StaticOrder, true, true>(lds, g, S, E, wave0); }
        else { pg8::Gemm g{AO, (const f16_t*)(ws + WS_WB), SEQ, DM, ATW, 0u, 0u}; pg8::gemm_phase<pg8::EpiBranch<true, MIX_F8>, pg8::StaticOrder>(lds, g, S, E, wave0); }
    }
    SEAM(10);
    if (IN(11)) {
        FRESH_IDS
        pg8::StaticOrder S; S.init(SEQ, DM, G, bx);
        pg8::EpiResidH<true, true> E{X1H, X1H, ada + 5 * DM, 1.0f, DM};
        if constexpr (MIX_F8) { pg8::Gemm g{ZV, (const f16_t*)(ws + WS_WO), SEQ, DM, DM / 2, E8M0_GU, E8M0_1}; pg8::gemm_phase<pg8::EpiResidH<true, true>, pg8::StaticOrder, true, true>(lds, g, S, E, wave0); }
        else { pg8::Gemm g{NB, (const f16_t*)(ws + WS_WO), SEQ, DM, DM, 0u, 0u}; pg8::gemm_phase<pg8::EpiResidH<true, true>, pg8::StaticOrder>(lds, g, S, E, wave0); }
    }
    SEAM(11);
    if (IN(12)) {
        FRESH_IDS
        LAS float* la = (LAS float*)lds; LAS float* lsh = la + DM;
        const float* g3 = argp(20);
        for (int c = tid; c < DM; c += NT) { la[c] = g3[c] * (1.0f + ada[7 * DM + c]); lsh[c] = ada[6 * DM + c]; }
        __syncthreads();
        norm_rows_h<FFN2_F8>(X1H, NB, la, lsh, gw, ngw, lane);
        if (FFN2_F8) zero_h_pad((f8_t*)HB, gw, ngw, lane);
        __syncthreads();
        LAS float* scr = (LAS float*)(lds + wave * 9216);
        if (!(EARLY_W2 && G == 256)) convert_ffn_gu<FFN2_F8>(argp(21), argp(22), Wt, scr, gw, ngw, lane);
    }
    SEAM(12);
    if (IN(13)) {
        FRESH_IDS
        if constexpr (FFN2_F8) { pg8::Gemm g{NB, (EARLY_W2 && G == 256) ? (const f16_t*)(ws + WS_WFF2) : Wt, SEQ, 2 * DFF, DM / 2, E8M0_GU, E8M0_1}; pg8::StaticOrder S; S.init(SEQ, 2 * DFF, G, bx);
            pg8::EpiSwiGLU<true> E{HB, DFF8}; pg8::gemm_phase<pg8::EpiSwiGLU<true>, pg8::StaticOrder, true, true>(lds, g, S, E, wave0); }
        else { pg8::Gemm g{NB, Wt, SEQ, 2 * DFF, DM, 0u, 0u}; pg8::StaticOrder S; S.init(SEQ, 2 * DFF, G, bx);
            pg8::EpiSwiGLU<false> E{HB, DFF}; pg8::gemm_phase<pg8::EpiSwiGLU<false>, pg8::StaticOrder>(lds, g, S, E, wave0); }
        convert_down_in_tail<FFN2_F8>(argp(23), Wd, lds, bx, G, wave, lane);
    }
    SEAM(13);
    if (IN(14)) {
        FRESH_IDS
        pg8::StaticOrder S; S.init(SEQ, DM, G, bx);
        pg8::EpiResidH<true, false> E{X1H, out, ada + 8 * DM, 0.5f, DM};
        if constexpr (FFN2_F8) { pg8::Gemm g{HB, Wd, SEQ, DM, DFF8 / 2, E8M0_DH, E8M0_1}; pg8::gemm_phase<pg8::EpiResidH<true, false>, pg8::StaticOrder, true, true>(lds, g, S, E, wave0); }
        else { pg8::Gemm g{HB, Wd, SEQ, DM, DFF, 0u, 0u}; pg8::gemm_phase<pg8::EpiResidH<true, false>, pg8::StaticOrder>(lds, g, S, E, wave0); }
    }
#undef IN
#undef SEAM
}

extern "C" void kernel_launch(void* const* d_in, const int* in_sizes, int n_in, void* d_out, int out_size, void* d_ws, size_t ws_size, hipStream_t stream) {
    static int grid = 0;
    if (grid == 0) {
        if (n_in != 24 || in_sizes[0] != SEQ * DM || out_size != SEQ * DM || ws_size < WS_END) { fprintf(stderr, "kernel_launch: unexpected shapes (n_in %d, in0 %d, out %d, ws %zu)\n", n_in, n_in > 0 ? in_sizes[0] : -1, out_size, ws_size); grid = -1; return; }
        int dev = 0, cus = 0;
        if (hipGetDevice(&dev) != hipSuccess || hipDeviceGetAttribute(&cus, hipDeviceAttributeMultiprocessorCount, dev) != hipSuccess) { grid = -1; return; }
        if (hipFuncSetAttribute((const void*)fwd_kernel, hipFuncAttributeMaxDynamicSharedMemorySize, LDS_BYTES) != hipSuccess) { fprintf(stderr, "kernel_launch: hipFuncSetAttribute failed\n"); grid = -1; return; }
        int per_cu = 0;
        if (hipOccupancyMaxActiveBlocksPerMultiprocessor(&per_cu, (const void*)fwd_kernel, NT, LDS_BYTES) != hipSuccess || per_cu < 1) fprintf(stderr, "kernel_launch: occupancy query says %d\n", per_cu);
        (void)hipGetLastError();
        grid = cus;
    }
    if (grid < 0) return;
    (void)hipMemsetAsync((char*)d_ws + WS_CTL, 0, CTL_ZERO_BYTES, stream);
    Args a{};
    for (int i = 0; i < 24; ++i) a.in[i] = (const float*)d_in[i];
    a.out = (float*)d_out; a.ws = (unsigned char*)d_ws;
    a.ph_lo = 0; a.ph_hi = N_PHASES;
    hipLaunchKernelGGL(fwd_kernel, dim3(grid), dim3(NT), LDS_BYTES, stream, a);
}
```
